# Optimizing an MI355X kernel written in HIP

```python
import math
import jax, jax.numpy as jnp
from jax import lax
import numpy as np

D_MODEL = 2048
BATCH = 2
SEQ = 4096
DEPTH = 1

D_MIX = D_MODEL
D_ATTN = D_MIX // 2
D_CONV = D_MIX - D_ATTN
N_HEADS = 8
DV = D_ATTN // N_HEADS
DQ = DV // 2
ROT_DIM = DQ // 4
ROPE_THETA = 500000.0
CONV_WIDTH = 31
CONV_GROUPS = 8
Q_BLOCK = 128
EPS = 1e-6
D_IN = 3 * D_ATTN + D_ATTN + 2 * D_CONV + D_CONV

kernel_name = "hymba_diffattn_conformer_conv_layer"


def rmsnorm(x, g):
    xf = x.astype(jnp.float32)
    y = xf * lax.rsqrt(jnp.mean(xf * xf, axis=-1, keepdims=True) + EPS)
    return (y * g.astype(jnp.float32)).astype(x.dtype)


def layernorm(x, g, b):
    xf = x.astype(jnp.float32)
    mu = jnp.mean(xf, axis=-1, keepdims=True)
    var = jnp.mean(jnp.square(xf - mu), axis=-1, keepdims=True)
    y = (xf - mu) * lax.rsqrt(var + EPS)
    return (y * g.astype(jnp.float32) + b.astype(jnp.float32)).astype(x.dtype)


def rope_tables(positions):
    inv_freq = ROPE_THETA ** (-jnp.arange(0, ROT_DIM, 2, dtype=jnp.float32) / ROT_DIM)
    ang = positions.astype(jnp.float32)[..., None] * inv_freq
    return jnp.cos(ang), jnp.sin(ang)


def apply_partial_rope(t, cos, sin):
    cos = cos[:, :, None, None, :].astype(t.dtype)
    sin = sin[:, :, None, None, :].astype(t.dtype)
    t_rot, t_pass = t[..., :ROT_DIM], t[..., ROT_DIM:]
    t1, t2 = t_rot[..., : ROT_DIM // 2], t_rot[..., ROT_DIM // 2:]
    rotated = jnp.concatenate([t1 * cos - t2 * sin, t2 * cos + t1 * sin], axis=-1)
    return jnp.concatenate([rotated, t_pass], axis=-1)


def diff_attention(q, k, v, lam):
    B, H, S = q.shape[0], q.shape[1], q.shape[2]
    scale = 1.0 / math.sqrt(DQ)
    kpos = jnp.arange(S)

    def one_block(i):
        start = i * Q_BLOCK
        qb = lax.dynamic_slice_in_dim(q, start, Q_BLOCK, axis=2)
        s = jnp.einsum('bhqcd,bhkcd->bhcqk', qb, k).astype(jnp.float32) * scale
        qpos = start + jnp.arange(Q_BLOCK)
        causal = kpos[None, :] <= qpos[:, None]
        s = jnp.where(causal, s, -1e30)
        p = jax.nn.softmax(s, axis=-1)
        a = p[:, :, 0] - lam * p[:, :, 1]
        return jnp.einsum('bhqk,bhkd->bhqd', a.astype(v.dtype), v)

    outs = lax.map(one_block, jnp.arange(S // Q_BLOCK))
    outs = jnp.transpose(outs, (1, 0, 3, 2, 4))
    return outs.reshape(B, S, H, DV)


def causal_depthwise_conv(y, w, b):
    out = lax.conv_general_dilated(
        y, w[:, None, :].astype(y.dtype), window_strides=(1,),
        padding=[(CONV_WIDTH - 1, 0)],
        dimension_numbers=('NWC', 'WIO', 'NWC'),
        feature_group_count=y.shape[-1])
    return out + b.astype(y.dtype)


def setup_inputs(seed: int = 0) -> dict:
    key = jax.random.key(seed)
    ks = jax.random.split(key, 24)
    f32 = jnp.float32
    nrm = lambda k, shape, s: jax.random.normal(k, shape, f32) * s
    return {
        "x": nrm(ks[0], (BATCH, SEQ, D_MODEL), 1.0),
        "c": nrm(ks[1], (BATCH, D_MODEL), 1.0),
        "positions": jnp.broadcast_to(jnp.arange(SEQ, dtype=jnp.int32), (BATCH, SEQ)),
        "norm_g": 1.0 + nrm(ks[2], (DEPTH, D_MODEL), 0.01),
        "w_ada": nrm(ks[3], (DEPTH, D_MODEL, 3 * D_MODEL), D_MODEL ** -0.5),
        "b_ada": nrm(ks[4], (DEPTH, 3 * D_MODEL), 0.01),
        "w_in": nrm(ks[5], (DEPTH, D_MODEL, D_IN), D_MODEL ** -0.5),
        "lambda_q1": nrm(ks[6], (DEPTH, DQ), 0.1),
        "lambda_k1": nrm(ks[7], (DEPTH, DQ), 0.1),
        "lambda_q2": nrm(ks[8], (DEPTH, DQ), 0.1),
        "lambda_k2": nrm(ks[9], (DEPTH, DQ), 0.1),
        "subln_g": 1.0 + nrm(ks[10], (DEPTH, DV), 0.01),
        "conv_dw_w": nrm(ks[11], (DEPTH, CONV_WIDTH, D_CONV), CONV_WIDTH ** -0.5),
        "conv_dw_b": nrm(ks[12], (DEPTH, D_CONV), 0.01),
        "conv_ln_g": 1.0 + nrm(ks[13], (DEPTH, D_CONV), 0.01),
        "conv_ln_b": nrm(ks[14], (DEPTH, D_CONV), 0.01),
        "w_pw": nrm(ks[15], (DEPTH, D_CONV, D_CONV), D_CONV ** -0.5),
        "b_pw": nrm(ks[16], (DEPTH, D_CONV), 0.01),
        "w_out": nrm(ks[17], (DEPTH, D_MIX, D_MODEL), D_MIX ** -0.5),
        "final_g": 1.0 + nrm(ks[18], (D_MODEL,), 0.01),
    }


def reference(x, c, positions, norm_g, w_ada, b_ada, w_in, lambda_q1, lambda_k1,
              lambda_q2, lambda_k2, subln_g, conv_dw_w, conv_dw_b, conv_ln_g, conv_ln_b,
              w_pw, b_pw, w_out, final_g):
    B, S, _ = x.shape
    cos, sin = rope_tables(positions)
    c_act = jax.nn.silu(c)
    splits = [D_ATTN, 2 * D_ATTN, 3 * D_ATTN, 4 * D_ATTN, 4 * D_ATTN + 2 * D_CONV]

    for l in range(DEPTH):
        mod = c_act @ w_ada[l] + b_ada[l]
        shift, scale, gate = jnp.split(mod, 3, axis=-1)
        h = rmsnorm(x, norm_g[l]) * (1.0 + scale[:, None, :]) + shift[:, None, :]

        z = h @ w_in[l]
        q, k, v, g_attn, u, g_conv = jnp.split(z, splits, axis=-1)

        lam_init = 0.8 - 0.6 * math.exp(-0.3 * l)
        lam = (jnp.exp(jnp.sum(lambda_q1[l].astype(jnp.float32) * lambda_k1[l].astype(jnp.float32)))
               - jnp.exp(jnp.sum(lambda_q2[l].astype(jnp.float32) * lambda_k2[l].astype(jnp.float32)))
               + lam_init)
        q = apply_partial_rope(q.reshape(B, S, N_HEADS, 2, DQ), cos, sin)
        k = apply_partial_rope(k.reshape(B, S, N_HEADS, 2, DQ), cos, sin)
        q = jnp.transpose(q, (0, 2, 1, 3, 4))
        k = jnp.transpose(k, (0, 2, 1, 3, 4))
        vh = jnp.transpose(v.reshape(B, S, N_HEADS, DV), (0, 2, 1, 3))
        o = diff_attention(q, k, vh, lam)
        o = rmsnorm(o, subln_g[l]) * (1.0 - lam_init)
        y_attn = o.reshape(B, S, D_ATTN) * jax.nn.silu(g_attn)

        u_a, u_b = jnp.split(u, 2, axis=-1)
        y = u_a * jax.nn.sigmoid(u_b)
        y = causal_depthwise_conv(y, conv_dw_w[l], conv_dw_b[l])
        y = jax.nn.silu(layernorm(y, conv_ln_g[l], conv_ln_b[l]))
        y = y @ w_pw[l] + b_pw[l]
        y_conv = y * jax.nn.silu(g_conv)

        mixed = jnp.concatenate([y_attn, y_conv], axis=-1) @ w_out[l]
        x = x + gate[:, None, :] * mixed

    return rmsnorm(x, final_g)
```

```cpp
#include <hip/hip_runtime.h>
#include <cstdio>
#include <cstdint>
namespace pg8 {
#define PG8_LAS __attribute__((address_space(3)))
typedef unsigned short bf16_t;
typedef short bf16x8 __attribute__((ext_vector_type(8)));
typedef float f32x4 __attribute__((ext_vector_type(4)));
typedef unsigned u32x4 __attribute__((ext_vector_type(4)));
constexpr int BM = 256, BK = 64, HALF = 128, HTB = HALF * BK * 2  , STAGE_BYTES = 8 * HTB, NXCD = 8, WGM = 8;

__host__ __device__ __forceinline__ int lds_byte(int r, int c) { const int st = (r >> 4) * 2 + (c >> 5), rr = r & 15, cc = c & 31, ob = rr * 64 + cc * 2; return st * 1024 + (ob ^ (((ob >> 9) & 1) << 5)); }
__host__ __device__ __forceinline__ void stage_rc(int b, int& R, int& C) { const int st = b / 1024, sb = b % 1024, swz = sb ^ (((sb >> 9) & 1) << 5); R = (st >> 1) * 16 + swz / 64; C = (st & 1) * 32 + (swz % 64) / 2; }
__host__ __device__ __forceinline__ int perm32(int rho) { const int n = rho >> 4, i = rho & 15; return 8 * (i >> 2) + 4 * n + (i & 3); }

struct Unit { int pm, pn; };
struct Gemm { const bf16_t* A; const bf16_t* Bt; int M, N, K; };

struct StaticOrder {
    int nM, nN, nwg, G, c;
    __host__ __device__ void init(int M, int N, int G_, int c_) { nM = M / BM; nN = N / BM; nwg = nM * nN; G = G_; c = c_; }
    __host__ __device__ bool next(int i, Unit& u) const {
        const long L = (long)i * G + c; if (L >= nwg) return false;
        int wgid = (int)L; { const int q = nwg / NXCD, r = nwg % NXCD, xcd = wgid % NXCD, off = wgid / NXCD; wgid = (xcd < r ? xcd * (q + 1) : r * (q + 1) + (xcd - r) * q) + off; }
        const int nig = WGM * nN, gid = wgid / nig, fm = gid * WGM, gsz = (nM - fm) < WGM ? (nM - fm) : WGM;
        u.pm = fm + ((wgid % nig) % gsz); u.pn = (wgid % nig) / gsz; return true;
    }
    __device__ __forceinline__ void a_ready(const Unit&) const {}
    __device__ __forceinline__ void done(const Unit&) const {}
};

__device__ __forceinline__ unsigned cvt_pk_bf16(float lo, float hi) { unsigned r; asm volatile("v_cvt_pk_bf16_f32 %0, %1, %2" : "=v"(r) : "v"(lo), "v"(hi)); return r; }
__device__ __forceinline__ float fast_sigmoid(float x) { return __builtin_amdgcn_rcpf(1.0f + __expf(-x)); }
__device__ __forceinline__ float fast_silu(float x) { return x * fast_sigmoid(x); }
__device__ __forceinline__ void store8(bf16_t* p, f32x4 v0, f32x4 v1) {
    u32x4 w; w.x = cvt_pk_bf16(v0[0], v0[1]); w.y = cvt_pk_bf16(v0[2], v0[3]); w.z = cvt_pk_bf16(v1[0], v1[1]); w.w = cvt_pk_bf16(v1[2], v1[3]);
    *(__attribute__((address_space(1))) u32x4*)p = w;
}
__device__ __forceinline__ f32x4 silu4(f32x4 v) { return (f32x4){fast_silu(v[0]), fast_silu(v[1]), fast_silu(v[2]), fast_silu(v[3])}; }
__device__ __forceinline__ f32x4 sig4(f32x4 v) { return (f32x4){fast_sigmoid(v[0]), fast_sigmoid(v[1]), fast_sigmoid(v[2]), fast_sigmoid(v[3])}; }
__device__ __forceinline__ f32x4 bf_lo4(unsigned a, unsigned b) { return (f32x4){__uint_as_float(a << 16), __uint_as_float(a & 0xffff0000u), __uint_as_float(b << 16), __uint_as_float(b & 0xffff0000u)}; }

struct EpiIn {
    static constexpr bool PERM = true, AFTER_DRAIN = false;
    bf16_t *Q, *K, *V, *SGA, *YG, *SGC; const float* cs; float qscale;
    __device__ __forceinline__ void operator()(const f32x4 (&acc)[2][2][4][2], const Unit& u, int wr, int wc, int fr, int fq) const {
        const int pn = u.pn; const int row0 = u.pm * BM + wr * 64 + fr; const int cw = wc * 32 + 8 * fq;
        if (pn < 8) {
            bf16_t* base = (pn < 4 ? Q : K) + (pn & 3) * 256 + cw; const float sc = pn < 4 ? qscale : 1.f;
            const bool rot = ((wc & 1) == 0); const float sgn = fq == 0 ? -1.f : 1.f; const bool act = fq < 2;
#pragma unroll
            for (int ai = 0; ai < 2; ++ai) { f32x4 csv[4][4];
                if (rot) {
#pragma unroll
                    for (int m = 0; m < 4; ++m)
#pragma unroll
                        for (int k = 0; k < 4; ++k) csv[m][k] = *((const __attribute__((address_space(1))) f32x4*)(cs + (size_t)(row0 + ai * HALF + m * 16) * 16) + k); }
#pragma unroll
                for (int m = 0; m < 4; ++m) { const int row = row0 + ai * HALF + m * 16;
                    f32x4 c0 = {1.f, 1.f, 1.f, 1.f}, c1 = c0, s0 = {0.f, 0.f, 0.f, 0.f}, s1 = s0;
                    if (rot) { c0 = csv[m][0]; c1 = csv[m][1]; s0 = csv[m][2]; s1 = csv[m][3]; }
#pragma unroll
                    for (int bj = 0; bj < 2; ++bj) { f32x4 v0 = acc[ai][bj][m][0], v1 = acc[ai][bj][m][1];
                        if (rot) { f32x4 p0, p1;
#pragma unroll
                            for (int j = 0; j < 4; ++j) { p0[j] = __shfl_xor(v0[j], 16); p1[j] = __shfl_xor(v1[j], 16); }
                            if (act) { v0 = v0 * c0 + sgn * (p0 * s0); v1 = v1 * c1 + sgn * (p1 * s1); } }
                        v0 = v0 * sc; v1 = v1 * sc; store8(base + (size_t)row * 1024 + bj * HALF, v0, v1); } } }
        } else if (pn < 12) {
            bf16_t* base = V + (pn - 8) * 256 + cw;
#pragma unroll
            for (int ai = 0; ai < 2; ++ai)
#pragma unroll
                for (int m = 0; m < 4; ++m) { const int row = row0 + ai * HALF + m * 16;
#pragma unroll
                    for (int bj = 0; bj < 2; ++bj) store8(base + (size_t)row * 1024 + bj * HALF, acc[ai][bj][m][0], acc[ai][bj][m][1]); }
        } else if (pn < 16 || pn >= 24) {
            bf16_t* base = (pn < 16 ? SGA + (pn - 12) * 256 : SGC + (pn - 24) * 256) + cw;
#pragma unroll
            for (int ai = 0; ai < 2; ++ai)
#pragma unroll
                for (int m = 0; m < 4; ++m) { const int row = row0 + ai * HALF + m * 16;
#pragma unroll
                    for (int bj = 0; bj < 2; ++bj) store8(base + (size_t)row * 1024 + bj * HALF, silu4(acc[ai][bj][m][0]), silu4(acc[ai][bj][m][1])); }
        } else {
            bf16_t* base = YG + (pn - 16) * 128 + cw;
#pragma unroll
            for (int ai = 0; ai < 2; ++ai)
#pragma unroll
                for (int m = 0; m < 4; ++m) { const int row = row0 + ai * HALF + m * 16;
                    store8(base + (size_t)row * 1024, acc[ai][0][m][0] * sig4(acc[ai][1][m][0]), acc[ai][0][m][1] * sig4(acc[ai][1][m][1])); }
        }
    }
};
struct EpiPw {
    static constexpr bool PERM = true, AFTER_DRAIN = false;
    const float* bias; const bf16_t* SGC; bf16_t* MIX;
    __device__ __forceinline__ void operator()(const f32x4 (&acc)[2][2][4][2], const Unit& u, int wr, int wc, int fr, int fq) const {
        const int row0 = u.pm * BM + wr * 64 + fr; const int col0 = u.pn * BM + wc * 32 + 8 * fq;
        f32x4 bv[2][2];
#pragma unroll
        for (int bj = 0; bj < 2; ++bj)
#pragma unroll
            for (int n = 0; n < 2; ++n) bv[bj][n] = *(const f32x4*)(bias + col0 + bj * HALF + 4 * n);
#pragma unroll
        for (int ai = 0; ai < 2; ++ai) { u32x4 gq[4][2];
#pragma unroll
            for (int m = 0; m < 4; ++m)
#pragma unroll
                for (int bj = 0; bj < 2; ++bj) gq[m][bj] = *(const __attribute__((address_space(1))) u32x4*)(SGC + (size_t)(row0 + ai * HALF + m * 16) * 1024 + col0 + bj * HALF);
#pragma unroll
            for (int m = 0; m < 4; ++m) { const int row = row0 + ai * HALF + m * 16;
#pragma unroll
                for (int bj = 0; bj < 2; ++bj) { const u32x4 g = gq[m][bj];
                    const f32x4 v0 = (acc[ai][bj][m][0] + bv[bj][0]) * bf_lo4(g.x, g.y), v1 = (acc[ai][bj][m][1] + bv[bj][1]) * bf_lo4(g.z, g.w);
                    store8(MIX + (size_t)row * 2048 + 1024 + col0 + bj * HALF, v0, v1); } } }
    }
};
struct EpiOut {
    static constexpr bool PERM = true, AFTER_DRAIN = false;
    const float* x; const float* gate; float* out; float* part;
    __device__ __forceinline__ void operator()(const f32x4 (&acc)[2][2][4][2], const Unit& u, int wr, int wc, int fr, int fq) const {
        const int row0 = u.pm * BM + wr * 64 + fr; const int col0 = u.pn * BM + wc * 32 + 8 * fq;
        const float* gp = gate + (size_t)((u.pm * BM) / 4096) * 6144 + 4096 + col0;
        f32x4 gv[2][2];
#pragma unroll
        for (int bj = 0; bj < 2; ++bj)
#pragma unroll
            for (int n = 0; n < 2; ++n) gv[bj][n] = *(const f32x4*)(gp + bj * HALF + 4 * n);
#pragma unroll
        for (int ai = 0; ai < 2; ++ai)
#pragma unroll
            for (int m = 0; m < 4; ++m) { const int row = row0 + ai * HALF + m * 16; float s = 0.f;
#pragma unroll
                for (int bj = 0; bj < 2; ++bj)
#pragma unroll
                    for (int n = 0; n < 2; ++n) { const size_t off = (size_t)row * 2048 + col0 + bj * HALF + 4 * n;
                        const f32x4 v = *(const f32x4*)(x + off) + gv[bj][n] * acc[ai][bj][m][n];
                        *(f32x4*)(out + off) = v; s += (v[0] * v[0] + v[1] * v[1]) + (v[2] * v[2] + v[3] * v[3]); }
                s += __shfl_xor(s, 16); s += __shfl_xor(s, 32);
                if (fq == 0) part[(size_t)row * 32 + u.pn * 4 + wc] = s; }
    }
};


struct EpiOutNorm {
    static constexpr bool PERM = true, AFTER_DRAIN = true;
    const float* x; const float* gate; const float* fg; float* out; unsigned* xbuf; unsigned* cnt; float eps;
    __device__ __forceinline__ void fused(f32x4 (&acc)[2][2][4][2], const Unit& u, int wr, int wc, int fr, int fq, PG8_LAS unsigned char* lds, int wid, int lane) const {
        PG8_LAS float* P = (PG8_LAS float*)lds;
        PG8_LAS float* S = (PG8_LAS float*)(lds + 4096);
        const int col0 = u.pn * BM + wc * 32 + 8 * fq;
        const float* gp = gate + (size_t)((u.pm * BM) / 4096) * 6144 + 4096 + col0;
        f32x4 gv[2][2];
#pragma unroll
        for (int bj = 0; bj < 2; ++bj)
#pragma unroll
            for (int n = 0; n < 2; ++n) gv[bj][n] = *(const f32x4*)(gp + bj * HALF + 4 * n);
#pragma unroll
        for (int ai = 0; ai < 2; ++ai) { f32x4 xv[4][2][2];
#pragma unroll
            for (int m = 0; m < 4; ++m)
#pragma unroll
                for (int bj = 0; bj < 2; ++bj)
#pragma unroll
                    for (int n = 0; n < 2; ++n) xv[m][bj][n] = __builtin_nontemporal_load((const __attribute__((address_space(1))) f32x4*)(x + (size_t)(u.pm * BM + ai * HALF + wr * 64 + m * 16 + fr) * 2048 + col0 + bj * HALF + 4 * n));
#pragma unroll
            for (int m = 0; m < 4; ++m) { const int rl = ai * HALF + wr * 64 + m * 16 + fr; float s = 0.f;
#pragma unroll
                for (int bj = 0; bj < 2; ++bj)
#pragma unroll
                    for (int n = 0; n < 2; ++n) { const f32x4 v = xv[m][bj][n] + gv[bj][n] * acc[ai][bj][m][n];
                        acc[ai][bj][m][n] = v; s += (v[0] * v[0] + v[1] * v[1]) + (v[2] * v[2] + v[3] * v[3]); }
                s += __shfl_xor(s, 16); s += __shfl_xor(s, 32);
                if (fq == 0) P[rl * 4 + wc] = s; } }
        asm volatile("s_waitcnt lgkmcnt(0)" ::: "memory"); __builtin_amdgcn_s_barrier(); asm volatile("" ::: "memory");
        const int rrow = wid * 32 + (lane & 31);
        if (lane < 32) { const float t = (P[rrow * 4 + 0] + P[rrow * 4 + 1]) + (P[rrow * 4 + 2] + P[rrow * 4 + 3]);
            __hip_atomic_store(xbuf + (size_t)(u.pm * BM + rrow) * 8 + u.pn, __float_as_uint(t), __ATOMIC_RELAXED, __HIP_MEMORY_SCOPE_AGENT); }
        asm volatile("s_waitcnt vmcnt(0)" ::: "memory");
        if (lane == 0) __hip_atomic_fetch_add(cnt + 64 * u.pm, 1u, __ATOMIC_RELAXED, __HIP_MEMORY_SCOPE_AGENT);
        if (wid == 0) { unsigned sp = 0;
            for (;;) { if ((unsigned)__builtin_amdgcn_readfirstlane(__hip_atomic_load(cnt + 64 * u.pm, __ATOMIC_RELAXED, __HIP_MEMORY_SCOPE_AGENT)) >= 64u) break;
                if (++sp > (1u << 22)) break; __builtin_amdgcn_s_sleep(2); }
            __builtin_amdgcn_fence(__ATOMIC_ACQUIRE, "agent"); }
        asm volatile("s_waitcnt vmcnt(0) lgkmcnt(0)" ::: "memory"); __builtin_amdgcn_s_barrier(); asm volatile("" ::: "memory");
        if (lane < 32) { const unsigned* slot = xbuf + (size_t)(u.pm * BM + rrow) * 8; float t = 0.f;
#pragma unroll
            for (int p = 0; p < 8; ++p) t += __uint_as_float(__hip_atomic_load(slot + p, __ATOMIC_RELAXED, __HIP_MEMORY_SCOPE_AGENT));
            S[rrow] = 1.0f / sqrtf(t * (1.0f / 2048.0f) + eps); }
        asm volatile("s_waitcnt lgkmcnt(0)" ::: "memory"); __builtin_amdgcn_s_barrier(); asm volatile("" ::: "memory");
        f32x4 fv[2][2];
#pragma unroll
        for (int bj = 0; bj < 2; ++bj)
#pragma unroll
            for (int n = 0; n < 2; ++n) fv[bj][n] = *(const f32x4*)(fg + col0 + bj * HALF + 4 * n);
#pragma unroll
        for (int ai = 0; ai < 2; ++ai)
#pragma unroll
            for (int m = 0; m < 4; ++m) { const int rl = ai * HALF + wr * 64 + m * 16 + fr; const float rs = S[rl];
#pragma unroll
                for (int bj = 0; bj < 2; ++bj)
#pragma unroll
                    for (int n = 0; n < 2; ++n) { const size_t off = (size_t)(u.pm * BM + rl) * 2048 + col0 + bj * HALF + 4 * n;
                        *(f32x4*)(out + off) = acc[ai][bj][m][n] * rs * fv[bj][n]; } }
    }
};


struct EpiGateAttn {
    static constexpr bool PERM = true, AFTER_DRAIN = true;
    const bf16_t* O1; const bf16_t* O2; const float* subln_g; bf16_t* MIX; float lam, eps;
    __device__ __forceinline__ void fused(f32x4 (&acc)[2][2][4][2], const Unit& u, int wr, int wc, int fr, int fq, PG8_LAS unsigned char* lds, int wid, int lane) const {
        PG8_LAS float* P = (PG8_LAS float*)lds;
        const int cw = wc * 32 + 8 * fq, dim0 = (u.pn - 12) * 256 + cw;
#pragma unroll
        for (int ai = 0; ai < 2; ++ai)
#pragma unroll
            for (int m = 0; m < 4; ++m) { const int rl = ai * HALF + wr * 64 + m * 16 + fr; const size_t ro = (size_t)(u.pm * BM + rl) * 1024 + dim0;
#pragma unroll
                for (int bj = 0; bj < 2; ++bj) { const u32x4 a = *(const u32x4*)(O1 + ro + bj * HALF), b = *(const u32x4*)(O2 + ro + bj * HALF);
                    const f32x4 o0 = bf_lo4(a.x, a.y) - lam * bf_lo4(b.x, b.y), o1 = bf_lo4(a.z, a.w) - lam * bf_lo4(b.z, b.w);
                    float s = (o0[0] * o0[0] + o0[1] * o0[1]) + (o0[2] * o0[2] + o0[3] * o0[3]) + (o1[0] * o1[0] + o1[1] * o1[1]) + (o1[2] * o1[2] + o1[3] * o1[3]);
                    s += __shfl_xor(s, 16); s += __shfl_xor(s, 32);
                    if (fq == 0) P[(rl * 2 + bj) * 4 + wc] = s; } }
        asm volatile("s_waitcnt lgkmcnt(0)" ::: "memory"); __builtin_amdgcn_s_barrier(); asm volatile("" ::: "memory");
        f32x4 gs[2];
#pragma unroll
        for (int n = 0; n < 2; ++n) gs[n] = *(const f32x4*)(subln_g + cw + 4 * n) * 0.8f;
#pragma unroll
        for (int ai = 0; ai < 2; ++ai)
#pragma unroll
            for (int m = 0; m < 4; ++m) { const int rl = ai * HALF + wr * 64 + m * 16 + fr; const size_t ro = (size_t)(u.pm * BM + rl) * 1024 + dim0;
#pragma unroll
                for (int bj = 0; bj < 2; ++bj) { const f32x4 p = *(const PG8_LAS f32x4*)(P + (rl * 2 + bj) * 4);
                    const float rs = 1.0f / sqrtf(((p[0] + p[1]) + (p[2] + p[3])) * (1.0f / 128.0f) + eps);
                    const u32x4 a = *(const u32x4*)(O1 + ro + bj * HALF), b = *(const u32x4*)(O2 + ro + bj * HALF);
                    const f32x4 o0 = bf_lo4(a.x, a.y) - lam * bf_lo4(b.x, b.y), o1 = bf_lo4(a.z, a.w) - lam * bf_lo4(b.z, b.w);
                    store8(MIX + (size_t)(u.pm * BM + rl) * 2048 + dim0 + bj * HALF, o0 * rs * gs[0] * silu4(acc[ai][bj][m][0]), o1 * rs * gs[1] * silu4(acc[ai][bj][m][1])); } }
    }
};
struct OrderSkipGA { StaticOrder o;
    __device__ bool next(int i, Unit& u) const { if (!o.next(i, u)) return false; if (u.pn >= 12) u.pn += 4; return true; }
    __device__ __forceinline__ void a_ready(const Unit&) const {}
    __device__ __forceinline__ void done(const Unit&) const {} };
struct OrderOne { int pm, pn;
    __device__ bool next(int i, Unit& u) const { if (i > 0 || pm < 0) return false; u.pm = pm; u.pn = pn; return true; }
    __device__ __forceinline__ void a_ready(const Unit&) const {}
    __device__ __forceinline__ void done(const Unit&) const {} };
struct OrderGA { int j;
    __device__ bool next(int i, Unit& u) const { if (i > 0 || j < 0 || j >= 128) return false; u.pm = j >> 2; u.pn = 12 + (j & 3); return true; }
    __device__ __forceinline__ void a_ready(const Unit&) const {}
    __device__ __forceinline__ void done(const Unit&) const {} };

template <class Epi, class Sched, bool ALIGN_EPI = false, bool SP2 = false>
__device__ __forceinline__ void gemm_phase(PG8_LAS unsigned char* lds, const Gemm g, const Sched& S, const Epi& E) {
    const int tid = threadIdx.x, wid = __builtin_amdgcn_readfirstlane(tid >> 6), lane = tid & 63, wr = wid >> 2, wc = wid & 3, fr = lane & 15, fq = lane >> 4;
    const int K = g.K, nt = K / BK;
    unsigned voffA[2], voffB[2];
#pragma unroll
    for (int i = 0; i < 2; ++i) { int R, C; stage_rc(tid * 16 + i * 8192, R, C); const int Rb = Epi::PERM ? ((R & ~31) + perm32(R & 31)) : R;
        voffA[i] = (unsigned)(R * K + C) * 2u; voffB[i] = (unsigned)(Rb * K + C) * 2u; }
    const size_t kstep = (size_t)(BK * 2);
    const size_t hstep = (size_t)HALF * K * 2;
    const size_t tstep = 2 * hstep;
    const unsigned ldsw = (unsigned)wid * 1024u;
    const int aoff = lds_byte(wr * 64 + fr, fq * 8), boff = lds_byte(wc * 32 + fr, fq * 8);
#define PG8_SA(b, h) (((b) * 2 + (h)) * HTB)
#define PG8_SB(b, h) ((4 + (b) * 2 + (h)) * HTB)
#define PG8_STAGE(bufoff, gbase, voff) do { _Pragma("unroll") for (int _i = 0; _i < 2; ++_i) \
        __builtin_amdgcn_global_load_lds((const unsigned*)((const char*)(gbase) + (voff)[_i]), (PG8_LAS unsigned*)(lds + (bufoff) + ldsw + _i * 8192), 16, 0, 0); } while (0)
#define PG8_LDA(dst, b, h) do { _Pragma("unroll") for (int m = 0; m < 4; ++m) _Pragma("unroll") for (int k = 0; k < 2; ++k) dst[m][k] = *(const PG8_LAS bf16x8*)(lds + PG8_SA(b, h) + aoff + m * 2048 + k * 1024); } while (0)
#define PG8_LDB(dst, b, h) do { _Pragma("unroll") for (int n = 0; n < 2; ++n) _Pragma("unroll") for (int k = 0; k < 2; ++k) dst[n][k] = *(const PG8_LAS bf16x8*)(lds + PG8_SB(b, h) + boff + n * 2048 + k * 1024); } while (0)
#define PG8_MMA(ai, bj, At, Bt) do { __builtin_amdgcn_s_setprio(1); _Pragma("unroll") for (int m = 0; m < 4; ++m) _Pragma("unroll") for (int n = 0; n < 2; ++n) _Pragma("unroll") for (int k = 0; k < 2; ++k) \
        acc[ai][bj][m][n] = __builtin_amdgcn_mfma_f32_16x16x32_bf16(Bt[n][k], At[m][k], acc[ai][bj][m][n], 0, 0, 0); __builtin_amdgcn_s_setprio(0); } while (0)
#define PG8_WAIT_V(n) asm volatile("s_waitcnt vmcnt(" #n ")" ::: "memory")
#define PG8_WAIT_L(n) asm volatile("s_waitcnt lgkmcnt(" #n ")" ::: "memory")
#define PG8_BAR __builtin_amdgcn_s_barrier()
#define PG8_SCHED __builtin_amdgcn_sched_barrier(0)
    Unit cur, nxt; int ui = 0;
    if (!S.next(0, cur)) return;
    f32x4 acc[2][2][4][2];
#pragma unroll
    for (int a = 0; a < 2; ++a)
#pragma unroll
        for (int b = 0; b < 2; ++b)
#pragma unroll
            for (int m = 0; m < 4; ++m)
#pragma unroll
                for (int n = 0; n < 2; ++n) acc[a][b][m][n] = (f32x4){0.f, 0.f, 0.f, 0.f};
    bf16x8 At[4][2], B0[2][2], B1[2][2];
    const char* cA = (const char*)g.A + (size_t)cur.pm * tstep; const char* cB = (const char*)g.Bt + (size_t)cur.pn * tstep;
    S.a_ready(cur);
    if constexpr (SP2) {
        PG8_STAGE(PG8_SB(0, 0), cB, voffB); PG8_STAGE(PG8_SB(0, 1), cB + hstep, voffB); PG8_STAGE(PG8_SA(0, 0), cA, voffA); PG8_STAGE(PG8_SA(0, 1), cA + hstep, voffA);
        if (wr == 1) PG8_BAR;
        PG8_WAIT_V(2); PG8_BAR;
        PG8_STAGE(PG8_SB(1, 0), cB + kstep, voffB); PG8_STAGE(PG8_SA(1, 0), cA + kstep, voffA); PG8_STAGE(PG8_SB(1, 1), cB + hstep + kstep, voffB);
        PG8_WAIT_V(6); PG8_BAR;
    } else {
        PG8_STAGE(PG8_SB(0, 0), cB, voffB); PG8_STAGE(PG8_SA(0, 0), cA, voffA); PG8_STAGE(PG8_SB(0, 1), cB + hstep, voffB); PG8_STAGE(PG8_SA(0, 1), cA + hstep, voffA);
        if (wr == 1) PG8_BAR;
        PG8_WAIT_V(4); PG8_BAR;
        PG8_STAGE(PG8_SB(1, 0), cB + kstep, voffB); PG8_STAGE(PG8_SA(1, 0), cA + kstep, voffA); PG8_STAGE(PG8_SB(1, 1), cB + hstep + kstep, voffB);
        PG8_WAIT_V(6); PG8_BAR;
    }
    for (;;) {
        const bool has_next = S.next(ui + 1, nxt);
        const char* nA = has_next ? (const char*)g.A + (size_t)nxt.pm * tstep : cA; const char* nB = has_next ? (const char*)g.Bt + (size_t)nxt.pn * tstep : cB;
        for (int t = 0; t < nt; t += 2) {
            const bool last = (t == nt - 2);
            const char* a1 = cA + (size_t)(t + 1) * kstep;
            const char* a2 = last ? nA : cA + (size_t)(t + 2) * kstep; const char* b2 = last ? nB : cB + (size_t)(t + 2) * kstep;
            const char* a3 = a2 + kstep; const char* b3 = b2 + kstep;
            if (last && has_next) S.a_ready(nxt);
            if constexpr (SP2) {
            PG8_LDB(B0, 0, 0); PG8_LDB(B1, 0, 1); PG8_SCHED; PG8_LDA(At, 0, 0); PG8_STAGE(PG8_SA(1, 1), a1 + hstep, voffA);
            PG8_WAIT_V(8); PG8_WAIT_L(0); PG8_BAR; PG8_MMA(0, 0, At, B0); PG8_MMA(0, 1, At, B1); PG8_BAR; PG8_SCHED;
            PG8_LDA(At, 0, 1); PG8_STAGE(PG8_SB(0, 0), b2, voffB); PG8_STAGE(PG8_SB(0, 1), b2 + hstep, voffB); PG8_STAGE(PG8_SA(0, 0), a2, voffA);
            PG8_WAIT_V(8); PG8_WAIT_L(0); PG8_BAR; PG8_MMA(1, 0, At, B0); PG8_MMA(1, 1, At, B1); PG8_BAR; PG8_SCHED;
            PG8_LDB(B0, 1, 0); PG8_LDB(B1, 1, 1); PG8_SCHED; PG8_LDA(At, 1, 0); PG8_STAGE(PG8_SA(0, 1), a2 + hstep, voffA);
            PG8_WAIT_V(8); PG8_WAIT_L(0); PG8_BAR; PG8_MMA(0, 0, At, B0); PG8_MMA(0, 1, At, B1); PG8_BAR; PG8_SCHED;
            PG8_LDA(At, 1, 1); PG8_STAGE(PG8_SB(1, 0), b3, voffB); PG8_STAGE(PG8_SB(1, 1), b3 + hstep, voffB); PG8_STAGE(PG8_SA(1, 0), a3, voffA);
            PG8_WAIT_V(8); PG8_WAIT_L(0); PG8_BAR; PG8_MMA(1, 0, At, B0); PG8_MMA(1, 1, At, B1); PG8_BAR; PG8_SCHED;
            } else {
            PG8_LDB(B0, 0, 0); PG8_SCHED; PG8_LDA(At, 0, 0); PG8_STAGE(PG8_SA(1, 1), a1 + hstep, voffA);
            PG8_WAIT_L(8); PG8_BAR; PG8_WAIT_L(0); PG8_MMA(0, 0, At, B0); PG8_BAR; PG8_SCHED;
            PG8_LDB(B1, 0, 1); PG8_STAGE(PG8_SB(0, 0), b2, voffB);
            PG8_BAR; PG8_WAIT_L(0); PG8_MMA(0, 1, At, B1); PG8_BAR;
            PG8_LDA(At, 0, 1); PG8_STAGE(PG8_SA(0, 0), a2, voffA);
            PG8_BAR; PG8_WAIT_L(0); PG8_MMA(1, 0, At, B0); PG8_BAR; PG8_SCHED;
            PG8_STAGE(PG8_SB(0, 1), b2 + hstep, voffB);
            PG8_WAIT_V(6); PG8_BAR; PG8_MMA(1, 1, At, B1); PG8_BAR;
            PG8_LDB(B0, 1, 0); PG8_SCHED; PG8_LDA(At, 1, 0); PG8_STAGE(PG8_SA(0, 1), a2 + hstep, voffA);
            PG8_WAIT_L(8); PG8_BAR; PG8_WAIT_L(0); PG8_MMA(0, 0, At, B0); PG8_BAR; PG8_SCHED;
            PG8_LDB(B1, 1, 1); PG8_STAGE(PG8_SB(1, 0), b3, voffB);
            PG8_BAR; PG8_WAIT_L(0); PG8_MMA(0, 1, At, B1); PG8_BAR;
            PG8_LDA(At, 1, 1); PG8_STAGE(PG8_SA(1, 0), a3, voffA);
            PG8_BAR; PG8_WAIT_L(0); PG8_MMA(1, 0, At, B0); PG8_BAR; PG8_SCHED;
            PG8_STAGE(PG8_SB(1, 1), b3 + hstep, voffB);
            PG8_WAIT_V(6); PG8_BAR; PG8_MMA(1, 1, At, B1); PG8_BAR;
            }
        }
        if constexpr (ALIGN_EPI) { if (wr == 0) PG8_BAR; }
        if constexpr (!Epi::AFTER_DRAIN) { E(acc, cur, wr, wc, fr, fq); S.done(cur); }
        if (!has_next) break;
#pragma unroll
        for (int a = 0; a < 2; ++a)
#pragma unroll
            for (int b = 0; b < 2; ++b)
#pragma unroll
                for (int m = 0; m < 4; ++m)
#pragma unroll
                    for (int n = 0; n < 2; ++n) acc[a][b][m][n] = (f32x4){0.f, 0.f, 0.f, 0.f};
        cur = nxt; cA = nA; cB = nB; ++ui;
        if constexpr (ALIGN_EPI) { if (wr == 1) PG8_BAR; }
    }
    PG8_WAIT_V(0);
    if constexpr (!ALIGN_EPI) { if (wr == 0) PG8_BAR; }
    PG8_BAR;
    if constexpr (Epi::AFTER_DRAIN) { E.fused(acc, cur, wr, wc, fr, fq, lds, wid, lane); S.done(cur); }
#undef PG8_SA
#undef PG8_SB
#undef PG8_STAGE
#undef PG8_LDA
#undef PG8_LDB
#undef PG8_MMA
#undef PG8_WAIT_V
#undef PG8_WAIT_L
#undef PG8_BAR
#undef PG8_SCHED
}
}

#ifndef PG8_SP2
#define PG8_SP2 true
#endif
#ifndef PG8_ALIGN
#define PG8_ALIGN true
#endif
#include <hip/hip_bf16.h>
#include <cmath>
namespace attn_body {
using bf16=__hip_bfloat16;
using bf16x8=__attribute__((ext_vector_type(8)))short;
using s16x4=__attribute__((ext_vector_type(4)))short;
using f32x16=__attribute__((ext_vector_type(16)))float;
using u32x4=__attribute__((ext_vector_type(4)))unsigned;
constexpr int BATCH=2,NHEAD=16,SEQ=4096,D=64,DM=NHEAD*D;
constexpr int NW=8,QBLK=32,QB=QBLK*NW,KVBLK=64,NQB=SEQ/QB;
constexpr int ATTN_PITCH=DM, ATTN_UNIT_ROWS=QB;
__device__ __forceinline__ int crow(int r,int hi){return (r&3)+8*(r>>2)+4*hi;}
#define SBAR() __builtin_amdgcn_sched_barrier(0)
__device__ __forceinline__ void cmask(f32x16&p0,f32x16&p1,int jb,int qrel,int hi){
  const float NEG=-INFINITY; int kb=64*jb+4*hi;
  #pragma unroll
  for(int r=0;r<16;++r){int kv=kb+(r&3)+8*(r>>2); if(kv>qrel)p0[r]=NEG; if(kv+32>qrel)p1[r]=NEG;}
}

constexpr int NSLOT=3, SLOTB=8192, VSLOTB=2*SLOTB;
constexpr int LDS_K=0, LDS_V=NSLOT*SLOTB, LDS_WS=LDS_V+NSLOT*VSLOTB, LDS_OST=LDS_WS+NW*64*4, LDS_BYTES=LDS_OST+NW*4096;
constexpr float C2=0.125f*1.4426950408889634f;
__device__ __forceinline__ void glds16(const void*gsrc,unsigned lds_dst){unsigned keep;
  asm volatile("s_mov_b32 %0, m0\n\ts_mov_b32 m0, %2\n\ts_nop 0\n\tglobal_load_lds_dwordx4 %1, off\n\ts_mov_b32 m0, %0":"=&s"(keep):"v"(gsrc),"s"(lds_dst):"memory");}
__device__ __forceinline__ float max3f(float a,float b,float c){float r;asm("v_max3_f32 %0, %1, %2, %3":"=v"(r):"v"(a),"v"(b),"v"(c));return r;}
__device__ __forceinline__ float max2f(float a,float b){float r;asm("v_max_f32_e32 %0, %1, %2":"=v"(r):"v"(a),"v"(b));return r;}
__device__ __forceinline__ float fadd_s(float a,float b){float r;asm("v_add_f32_e32 %0, %1, %2":"=v"(r):"v"(a),"v"(b));return r;}
__device__ __forceinline__ float fsub_s(float a,float b){float r;asm("v_sub_f32_e32 %0, %1, %2":"=v"(r):"v"(a),"v"(b));return r;}
typedef float f32x2_t __attribute__((ext_vector_type(2))); typedef __bf16 bf16x2_t __attribute__((ext_vector_type(2)));
__device__ __forceinline__ unsigned cvtpk_s(float lo,float hi){f32x2_t v={lo,hi};bf16x2_t b=__builtin_convertvector(v,bf16x2_t);return __builtin_bit_cast(unsigned,b);}
#define WAIT_BAR(N) asm volatile("s_waitcnt vmcnt(" #N ") lgkmcnt(0)\n\ts_barrier":::"memory")

__device__ __forceinline__ void qkt(f32x16&p0,f32x16&p1,const char*Kslot,const bf16x8*qr,const f32x16&negm,int r32,int hi){
  const char*kb=Kslot+hi*1024+r32*16;
  #pragma unroll
  for(int d0=0;d0<4;++d0){
    const bf16x8 b0=*reinterpret_cast<const bf16x8*>(kb+d0*2048);
    const bf16x8 b1=*reinterpret_cast<const bf16x8*>(kb+d0*2048+512);
    if(d0==0){p0=__builtin_amdgcn_mfma_f32_32x32x16_bf16(b0,qr[0],negm,0,0,0);p1=__builtin_amdgcn_mfma_f32_32x32x16_bf16(b1,qr[0],negm,0,0,0);}
    else{p0=__builtin_amdgcn_mfma_f32_32x32x16_bf16(b0,qr[d0],p0,0,0,0);p1=__builtin_amdgcn_mfma_f32_32x32x16_bf16(b1,qr[d0],p1,0,0,0);}}
}
typedef __attribute__((address_space(3))) const char* lds_cptr;
typedef short v4i16_t __attribute__((ext_vector_type(4)));
__device__ __forceinline__ void kload8(bf16x8*kf,lds_cptr kp){
  kf[0]=*(const __attribute__((address_space(3))) bf16x8*)(kp);      kf[1]=*(const __attribute__((address_space(3))) bf16x8*)(kp+512);
  kf[2]=*(const __attribute__((address_space(3))) bf16x8*)(kp+2048); kf[3]=*(const __attribute__((address_space(3))) bf16x8*)(kp+2560);
  kf[4]=*(const __attribute__((address_space(3))) bf16x8*)(kp+4096); kf[5]=*(const __attribute__((address_space(3))) bf16x8*)(kp+4608);
  kf[6]=*(const __attribute__((address_space(3))) bf16x8*)(kp+6144); kf[7]=*(const __attribute__((address_space(3))) bf16x8*)(kp+6656);
}
__device__ __forceinline__ void kload2(bf16x8*kf,lds_cptr kp,int j){ kf[2*j]=*(const __attribute__((address_space(3))) bf16x8*)(kp+j*2048); kf[2*j+1]=*(const __attribute__((address_space(3))) bf16x8*)(kp+j*2048+512); }
__device__ __forceinline__ s16x4 vtr(lds_cptr p){ return __builtin_bit_cast(s16x4,__builtin_amdgcn_ds_read_tr16_b64_v4i16((__attribute__((address_space(3))) v4i16_t*)p)); }
__device__ __forceinline__ float rowmax(const f32x16&p0,const f32x16&p1){
  float a=max3f(p0[0],p0[1],p1[0]),b=max3f(p0[2],p0[3],p1[1]);a=max3f(a,p1[2],p1[3]);
  #pragma unroll
  for(int r=4;r<16;r+=4){a=max3f(a,p0[r],p0[r+1]);b=max3f(b,p0[r+2],p0[r+3]);a=max3f(a,p1[r],p1[r+1]);b=max3f(b,p1[r+2],p1[r+3]);}
  const float m=max2f(a,b);
  auto rr=__builtin_amdgcn_permlane32_swap(__float_as_uint(m),__float_as_uint(m),false,false);
  return max2f(__uint_as_float(rr[0]),__uint_as_float(rr[1]));
}
__device__ __forceinline__ void pv(f32x16*o,int vb,bf16x8 pa0,bf16x8 pa1,bf16x8 pa2,bf16x8 pa3){
  #pragma unroll
  for(int d0=0;d0<4;++d0){s16x4 lo[4],hi[4];
    #pragma unroll
    for(int ks=0;ks<4;++ks){
      asm volatile("ds_read_b64_tr_b16 %0,%1 offset:%c2":"=&v"(lo[ks]):"v"(vb),"i"(d0*4096+ks*1024):"memory");
      asm volatile("ds_read_b64_tr_b16 %0,%1 offset:%c2":"=&v"(hi[ks]):"v"(vb),"i"(d0*4096+ks*1024+512):"memory");}
    asm volatile("s_waitcnt lgkmcnt(0)":::"memory");SBAR();
    #define PK(k) (bf16x8){lo[k][0],lo[k][1],lo[k][2],lo[k][3],hi[k][0],hi[k][1],hi[k][2],hi[k][3]}
    o[d0]=__builtin_amdgcn_mfma_f32_32x32x16_bf16(pa0,PK(0),o[d0],0,0,0);
    o[d0]=__builtin_amdgcn_mfma_f32_32x32x16_bf16(pa1,PK(1),o[d0],0,0,0);
    o[d0]=__builtin_amdgcn_mfma_f32_32x32x16_bf16(pa2,PK(2),o[d0],0,0,0);
    o[d0]=__builtin_amdgcn_mfma_f32_32x32x16_bf16(pa3,PK(3),o[d0],0,0,0);
    #undef PK
  }
}

#ifndef ATTN_STORE16
#define ATTN_STORE16(p,v) (*(u32x4*)(p)=(v))
#endif
template<int THRL> __device__ __forceinline__ void attn_unit(int b,int hq,int hv,int qb,const bf16*Q,const bf16*__restrict__ K,const bf16*__restrict__ V,bf16*O,char*shm){
  int tid_=threadIdx.x; asm volatile("":"+v"(tid_));
  const int tid=tid_,lane=tid&63,r32=lane&31,hi=lane>>5; const int wid=__builtin_amdgcn_readfirstlane(tid>>6);
  const long rowbase=(long)b*SEQ; const int q0=qb*QB;
  const bf16*Qw=Q+(rowbase+q0+wid*QBLK)*DM+hq*D;
  const bf16*Kh=K+rowbase*DM+hq*D,*Vh=V+rowbase*DM+hv*D;
  const unsigned lds0=(unsigned)(uintptr_t)shm;
  float*wsf=(float*)(shm+LDS_WS)+wid*64;
  typedef const __attribute__((address_space(3))) float* lds_cfptr; const lds_cfptr wsfh=(lds_cfptr)((const __attribute__((address_space(3))) char*)shm+LDS_WS)+wid*64+4*hi;
  #define CROW0(r) (((r)&3)+8*((r)>>2))
  const bf16*ksrc=Kh+(long)lane*DM+wid*8;
  const bf16*vsrc=Vh+(long)(16*(wid&3)+(lane>>2))*DM+(wid>>2)*32+(lane&3)*8;
  const unsigned kdst=lds0+LDS_K+wid*1024, vdst=lds0+LDS_V+wid*1024;
  #define DMA_K(t,slot) glds16(ksrc+(long)(t)*KVBLK*DM,(unsigned)__builtin_amdgcn_readfirstlane(kdst+(slot)))
  #define DMA_V(t,slot) do{ glds16(vsrc+(long)(t)*KVBLK*DM,(unsigned)__builtin_amdgcn_readfirstlane(vdst+2*(slot))); glds16(vsrc+(long)(t)*KVBLK*DM+64,(unsigned)__builtin_amdgcn_readfirstlane(vdst+2*(slot)+8192)); }while(0)
  const int vb0=(int)(lds0+LDS_V)+((lane>>4)&1)*32+(lane&3)*8+(4*hi+((lane&15)>>2))*64;
  const char*Kbase=shm+LDS_K; bf16x8 kf[8];
  const lds_cptr shm3=(lds_cptr)shm; const lds_cptr kp0=shm3+LDS_K+hi*1024+r32*16; const lds_cptr vp0=shm3+LDS_V+((lane>>4)&1)*32+(lane&3)*8+(4*hi+((lane&15)>>2))*64;
  const int NT=(q0+QB)/KVBLK;
  DMA_K(0,0);DMA_V(0,0);DMA_K(1,SLOTB);
  bf16x8 qr[4];
  #pragma unroll
  for(int d0=0;d0<4;++d0)qr[d0]=*reinterpret_cast<const bf16x8*>(&Qw[(long)r32*DM+d0*16+hi*8]);
  float mhat=0.f,l_reg=0.f;f32x16 o[4];o[0]=f32x16{};o[1]=f32x16{};o[2]=f32x16{};o[3]=f32x16{};f32x16 negm=f32x16{};asm volatile("":"+v"(negm));
  const int qrel=wid*QBLK+r32;
  #define CMASK(P0,P1,t) do{int jb_=(t)-(NT-4); if(jb_>=0)cmask(P0,P1,jb_,qrel,hi);}while(0)
  bool resc=false;
  #define START(P0,P1) do{ const float rm=rowmax(P0,P1); resc=false; \
    { const float dl=rm; mhat=fadd_s(mhat,dl); \
      _Pragma("unroll") for(int r=0;r<16;++r){P0[r]=fsub_s(P0[r],dl);P1[r]=fsub_s(P1[r],dl);} \
      _Pragma("unroll") for(int r=0;r<16;++r)negm[r]=-mhat; asm volatile("":"+v"(negm)); } \
    _Pragma("unroll") for(int r=0;r<16;++r)P0[r]=__builtin_amdgcn_exp2f(P0[r]); }while(0)
  #define RESC() do{ if(resc){ asm volatile("s_waitcnt lgkmcnt(0)":::"memory"); \
      _Pragma("unroll") for(int d_=0;d_<4;++d_) _Pragma("unroll") for(int r=0;r<16;++r)o[d_][r]*=wsfh[CROW0(r)]; } }while(0)
  f32x16 pA0,pA1,pB0,pB1;
  int sl_prev=0,sl_cur=0,sl_next=SLOTB;
  #define ROT() do{sl_prev=sl_cur;sl_cur=sl_next;sl_next=(sl_next==(NSLOT-1)*SLOTB)?0:sl_next+SLOTB;}while(0)
  DMA_K(2,2*SLOTB);
  WAIT_BAR(4);
  qkt(pA0,pA1,Kbase,qr,negm,r32,hi);asm volatile("s_nop 15\n\ts_nop 7":"+v"(pA0),"+v"(pA1));CMASK(pA0,pA1,0);
  START(pA0,pA1);
  _Pragma("unroll") for(int r=0;r<16;++r)pA1[r]=__builtin_amdgcn_exp2f(pA1[r]);
  WAIT_BAR(0);
  DMA_K(3,0);DMA_V(1,SLOTB);
  ROT();
  kload8(kf,kp0+sl_cur);
  WAIT_BAR(3);
  s16x4 vlo[8],vhi[8]; u32x4 pw0,pw1,pw2,pw3;
  #define PKW(P,B) cvtpk_s(P[B],P[B+1])
  #define PAF(k) __builtin_bit_cast(bf16x8,pw##k)
  #define VFR(i) (bf16x8){vlo[i][0],vlo[i][1],vlo[i][2],vlo[i][3],vhi[i][0],vhi[i][1],vhi[i][2],vhi[i][3]}
  #define PIN(x) asm volatile("":"+v"(x))
  #define MX3(a,b,c) __builtin_fmaxf(__builtin_fmaxf((a),(b)),(c))
  #define GAPA(MF,A0,A1,A2,A3,W0,W1,PW) do{ MF; sacc+=A0; sacc+=A1; sacc+=A2; sacc+=A3; PIN(sacc); W0; W1; PIN(PW); SBAR(); }while(0)
  #define EX(v) __builtin_amdgcn_exp2f(v)
  #define GAPB(MF,X,B) do{ MF; X[B]=EX(X[B]); X[B+1]=EX(X[B+1]); X[B+2]=EX(X[B+2]); X[B+3]=EX(X[B+3]); PIN(X); SBAR(); }while(0)
  #define GAPB2V(MF,F,X,B) do{ MF; VRD2(F); X[B]=EX(X[B]); X[B+1]=EX(X[B+1]); PIN(X); SBAR(); }while(0)
  #define GAPB2(MF,X,B) do{ MF; X[B]=EX(X[B]); X[B+1]=EX(X[B+1]); PIN(X); SBAR(); }while(0)
  #define VRD2(i) do{ vlo[i]=vtr(vp_+(8192+((i)>>2)*4096+((i)&3)*1024)); vhi[i]=vtr(vp_+(8192+((i)>>2)*4096+((i)&3)*1024+512)); }while(0)
  #define VRD(i) do{ vlo[i]=vtr(vp_+(((i)>>2)*4096+((i)&3)*1024)); vhi[i]=vtr(vp_+(((i)>>2)*4096+((i)&3)*1024+512)); }while(0)
  #define KRD(G,j) do{ if(G){ kload2(kf,kp0+sl_next,j); SBAR(); } }while(0)
  #define STEP(C0,C1,P0,P1,t,GK,GV,GL) do{ SBAR(); \
    const lds_cptr vp_=vp0+2*sl_prev; \
    VRD(0); SBAR(); float sacc=(P0[0]+P0[1]); \
    GAPA(C0=__builtin_amdgcn_mfma_f32_32x32x16_bf16(kf[0],qr[0],negm,0,0,0), P0[2],P0[3],P0[4],P0[5],     pw0[0]=PKW(P0,0), pw0[1]=PKW(P0,2), pw0); \
    VRD(4); SBAR(); GAPA(C1=__builtin_amdgcn_mfma_f32_32x32x16_bf16(kf[1],qr[0],negm,0,0,0), P0[6],P0[7],P0[8],P0[9],     pw0[2]=PKW(P0,4), pw0[3]=PKW(P0,6), pw0); \
    VRD(1); SBAR(); GAPA(C0=__builtin_amdgcn_mfma_f32_32x32x16_bf16(kf[2],qr[1],C0,0,0,0),   P0[10],P0[11],P0[12],P0[13], pw1[0]=PKW(P0,8), pw1[1]=PKW(P0,10), pw1); \
    VRD(5); SBAR(); GAPA(C1=__builtin_amdgcn_mfma_f32_32x32x16_bf16(kf[3],qr[1],C1,0,0,0),   P0[14],P0[15],P1[0],P1[1],   pw1[2]=PKW(P0,12),pw1[3]=PKW(P0,14), pw1); \
    VRD(2); SBAR(); GAPA(C0=__builtin_amdgcn_mfma_f32_32x32x16_bf16(kf[4],qr[2],C0,0,0,0),   P1[2],P1[3],P1[4],P1[5],     pw2[0]=PKW(P1,0), pw2[1]=PKW(P1,2), pw2); \
    VRD(6); SBAR(); GAPA(C1=__builtin_amdgcn_mfma_f32_32x32x16_bf16(kf[5],qr[2],C1,0,0,0),   P1[6],P1[7],P1[8],P1[9],     pw2[2]=PKW(P1,4), pw2[3]=PKW(P1,6), pw2); \
    VRD(3); SBAR(); GAPA(C0=__builtin_amdgcn_mfma_f32_32x32x16_bf16(kf[6],qr[3],C0,0,0,0),   P1[10],P1[11],P1[12],P1[13], pw3[0]=PKW(P1,8), pw3[1]=PKW(P1,10), pw3); \
    VRD(7); SBAR(); GAPA(C1=__builtin_amdgcn_mfma_f32_32x32x16_bf16(kf[7],qr[3],C1,0,0,0),   P1[14],P1[15],0.f,0.f,       pw3[2]=PKW(P1,12),pw3[3]=PKW(P1,14), pw3); \
    l_reg+=sacc; \
    if(GK){DMA_K((t)+3,sl_cur);} if(GV){DMA_V((t)+1,sl_next);} \
    CMASK(C0,C1,t); \
    { float a=MX3(C0[0],C0[1],C1[0]),b=MX3(C0[2],C0[3],C1[1]); a=MX3(a,C1[2],C1[3]); \
      _Pragma("unroll") for(int r=4;r<16;r+=4){a=MX3(a,C0[r],C0[r+1]);b=MX3(b,C0[r+2],C0[r+3]);a=MX3(a,C1[r],C1[r+1]);b=MX3(b,C1[r+2],C1[r+3]);} \
      float rm=__builtin_fmaxf(a,b); { auto rr=__builtin_amdgcn_permlane32_swap(__float_as_uint(rm),__float_as_uint(rm),false,false); rm=__builtin_fmaxf(__uint_as_float(rr[0]),__uint_as_float(rr[1])); } \
      resc=false; \
      if(__builtin_expect(__any(rm>(float)THRL),0)){ const float dl=__builtin_fmaxf(rm,0.f); mhat+=dl; \
        _Pragma("unroll") for(int r=0;r<16;++r){C0[r]-=dl;C1[r]-=dl;} \
        _Pragma("unroll") for(int r=0;r<16;++r)negm[r]=-mhat; asm volatile("":"+v"(negm)); \
        const float f=__builtin_amdgcn_exp2f(-dl); l_reg*=f; if(hi==0)wsf[r32]=f; resc=true; } } \
    SBAR(); \
    GAPB2V(o[0]=__builtin_amdgcn_mfma_f32_32x32x16_bf16(PAF(0),VFR(0),o[0],0,0,0), 0, C0,0); \
    GAPB2V(o[1]=__builtin_amdgcn_mfma_f32_32x32x16_bf16(PAF(0),VFR(4),o[1],0,0,0), 4, C0,2); \
    KRD(GL,0); GAPB2V(o[0]=__builtin_amdgcn_mfma_f32_32x32x16_bf16(PAF(1),VFR(1),o[0],0,0,0), 1, C0,4); \
    KRD(GL,1); GAPB2V(o[1]=__builtin_amdgcn_mfma_f32_32x32x16_bf16(PAF(1),VFR(5),o[1],0,0,0), 5, C0,6); \
    KRD(GL,2); GAPB2V(o[0]=__builtin_amdgcn_mfma_f32_32x32x16_bf16(PAF(2),VFR(2),o[0],0,0,0), 2, C0,8); \
    KRD(GL,3); GAPB2V(o[1]=__builtin_amdgcn_mfma_f32_32x32x16_bf16(PAF(2),VFR(6),o[1],0,0,0), 6, C0,10); \
    GAPB2V(o[0]=__builtin_amdgcn_mfma_f32_32x32x16_bf16(PAF(3),VFR(3),o[0],0,0,0), 3, C0,12); \
    GAPB2V(o[1]=__builtin_amdgcn_mfma_f32_32x32x16_bf16(PAF(3),VFR(7),o[1],0,0,0), 7, C0,14); \
    GAPB2(o[2]=__builtin_amdgcn_mfma_f32_32x32x16_bf16(PAF(0),VFR(0),o[2],0,0,0), C1,0); \
    GAPB2(o[3]=__builtin_amdgcn_mfma_f32_32x32x16_bf16(PAF(0),VFR(4),o[3],0,0,0), C1,2); \
    GAPB2(o[2]=__builtin_amdgcn_mfma_f32_32x32x16_bf16(PAF(1),VFR(1),o[2],0,0,0), C1,4); \
    GAPB2(o[3]=__builtin_amdgcn_mfma_f32_32x32x16_bf16(PAF(1),VFR(5),o[3],0,0,0), C1,6); \
    GAPB2(o[2]=__builtin_amdgcn_mfma_f32_32x32x16_bf16(PAF(2),VFR(2),o[2],0,0,0), C1,8); \
    GAPB2(o[3]=__builtin_amdgcn_mfma_f32_32x32x16_bf16(PAF(2),VFR(6),o[3],0,0,0), C1,10); \
    GAPB2(o[2]=__builtin_amdgcn_mfma_f32_32x32x16_bf16(PAF(3),VFR(3),o[2],0,0,0), C1,12); \
    GAPB2(o[3]=__builtin_amdgcn_mfma_f32_32x32x16_bf16(PAF(3),VFR(7),o[3],0,0,0), C1,14); \
    }while(0)
  int t=1;
  #undef CMASK
  #define CMASK(P0,P1,t) do{}while(0)
  for(;t+5<NT;t+=2){
    STEP(pB0,pB1,pA0,pA1,t,true,true,true);     WAIT_BAR(3); RESC(); ROT();
    STEP(pA0,pA1,pB0,pB1,t+1,true,true,true);   WAIT_BAR(3); RESC(); ROT();
  }
  #undef CMASK
  #define CMASK(P0,P1,t) do{int jb_=(t)-(NT-4); if(jb_>=0)cmask(P0,P1,jb_,qrel,hi);}while(0)
  #define ENDW(tt) do{ if((tt)+3<NT){WAIT_BAR(3);} else if((tt)+2<NT){WAIT_BAR(2);} else {WAIT_BAR(0);} }while(0)
  for(;t+1<NT;t+=2){
    STEP(pB0,pB1,pA0,pA1,t,(t+3<NT),(t+1<NT),(t+1<NT));       ENDW(t);   RESC(); ROT();
    STEP(pA0,pA1,pB0,pB1,t+1,(t+4<NT),(t+2<NT),(t+2<NT));     ENDW(t+1); RESC(); ROT();
  }
  STEP(pB0,pB1,pA0,pA1,NT-1,false,false,false); RESC();
  { float sacc=pB0[0]+pB0[1]; _Pragma("unroll") for(int r=2;r<16;++r)sacc+=pB0[r]; _Pragma("unroll") for(int r=0;r<16;++r)sacc+=pB1[r]; l_reg+=sacc;
    pw0=(u32x4){PKW(pB0,0),PKW(pB0,2),PKW(pB0,4),PKW(pB0,6)};pw1=(u32x4){PKW(pB0,8),PKW(pB0,10),PKW(pB0,12),PKW(pB0,14)};pw2=(u32x4){PKW(pB1,0),PKW(pB1,2),PKW(pB1,4),PKW(pB1,6)};pw3=(u32x4){PKW(pB1,8),PKW(pB1,10),PKW(pB1,12),PKW(pB1,14)};
    SBAR(); pv(o,vb0+2*sl_cur,PAF(0),PAF(1),PAF(2),PAF(3)); }
  #undef PKW
  #undef PAF
  #undef VFR
  #undef PIN
  #undef MX3
  #undef GAPA
  #undef GAPB
  #undef EX
  #undef VRD
  #undef VRD2
  #undef GAPB2
  #undef GAPB2V
  #undef KRD
  #undef STEP
  #undef ENDW
  {auto rr=__builtin_amdgcn_permlane32_swap(__float_as_uint(l_reg),__float_as_uint(l_reg),false,false);l_reg=__uint_as_float(rr[0])+__uint_as_float(rr[1]);}
  if(hi==0)wsf[32+r32]=l_reg;asm volatile("s_waitcnt lgkmcnt(0)":::"memory");
  float rli[16];
  #pragma unroll
  for(int r=0;r<16;++r)rli[r]=__builtin_amdgcn_rcpf(wsfh[32+CROW0(r)]);
  bf16*Ow=O+(rowbase+q0+wid*QBLK)*DM+hv*D;
  { bf16*stg=(bf16*)(shm+LDS_OST)+wid*2048;
    #pragma unroll
    for(int hf=0;hf<2;++hf){
    #pragma unroll
    for(int r=0;r<16;++r){const int orow=crow(r,hi);
      #pragma unroll
      for(int d0=0;d0<2;++d0)stg[orow*64+d0*32+r32]=__float2bfloat16(o[2*hf+d0][r]*rli[r]);}
    asm volatile("s_waitcnt lgkmcnt(0)":::"memory");
    #pragma unroll
    for(int i=0;i<4;++i){const int row=i*8+(lane>>3),ch=lane&7; const u32x4 v=*(const u32x4*)(stg+row*64+ch*8); ATTN_STORE16(Ow+(long)row*DM+hf*64+ch*8,v);}
    asm volatile("s_waitcnt lgkmcnt(0)":::"memory"); } }
  asm volatile("s_waitcnt lgkmcnt(0)\n\ts_barrier":::"memory");
  #undef DMA_K
  #undef DMA_V
  #undef CMASK
  #undef START
  #undef RESC
  #undef ROT
  #undef CROW0
}
constexpr int ATTN_LDS_BYTES=LDS_BYTES;
struct AttnTensors { const bf16* Q; const bf16* K; const bf16* V; bf16* O1; bf16* O2; };
struct AttnUnit { int bh; int qb; };
struct StaticOrder {
  int vcu, G;
  __device__ __forceinline__ explicit StaticOrder(int grid,int block):vcu((grid%8==0)?(block%8)*(grid/8)+block/8:block),G(grid){}
  __device__ __forceinline__ bool next(int i,AttnUnit&u)const{
    if(G==256){ if(i>=2)return false; const int s=vcu&7,t=s&3; u.bh=vcu>>3;
      const int hiq=(s<4)?((t<2)?15-t:13-t):((t<2)?13-t:11-t), loq=(s<4)?((t<2)?2+t:4+t):((t<2)?t:2+t);
      u.qb=(i==0)?loq:hiq; return true; }
    const int L=i*G+vcu; if(L>=32*NQB)return false; u.bh=L/NQB; u.qb=NQB-1-(L%NQB); return true; }
  __device__ __forceinline__ void a_ready(const AttnUnit&)const{}
  __device__ __forceinline__ void done(const AttnUnit&)const{}
};
template<class Sched,int THRL=8> __device__ __forceinline__ void attn_phase(char*lds,const AttnTensors&T,const Sched&S){
  AttnUnit u;
  for(int i=0;S.next(i,u);++i){ S.a_ready(u); const int c=u.bh&1,h=(u.bh>>1)&7,b=u.bh>>4;
    attn_unit<THRL>(b,2*h+c,2*h,u.qb,T.Q,T.K,T.V,c?T.O2:T.O1,lds); S.done(u); }
}
#undef SBAR
#undef WAIT_BAR
}
constexpr int NWAVES = 8;
#ifndef MK_N_LAUNCHES
#define MK_N_LAUNCHES 1
#endif
constexpr int N_LAUNCHES = MK_N_LAUNCHES;
#ifndef MK_REP
#define MK_REP {1,1,1,1,1,1}
#endif
constexpr int REP[6] = MK_REP;
constexpr int N_PHASES = 6;

constexpr int SEQ = 4096, DM = 2048, M = 2 * SEQ, DIN = 7168;
constexpr float EPS = 1e-6f;

constexpr size_t MiB = 1u << 20;
constexpr size_t WS_WIN = 2 * MiB, WS_WOUT = 30 * MiB, WS_WPW = 38 * MiB;
constexpr size_t WS_CTL = 0, CTL_ZERO_BYTES = 32768; constexpr int CW_PANEL = 4096, CW_CONV = 6144;
constexpr size_t WS_PTRS = 41 * MiB + 256 * 1024;
constexpr size_t WS_SMALL = 43 * MiB;
constexpr int S_LAM = 0, S_SUBLN = 256, S_DWB = 384, S_LNG = 1408, S_LNB = 2432, S_BPW = 3456, S_FG = 4480, S_NG = 6528, S_BADA = 8576, S_DWW = 14720, S_END = 46464;
constexpr size_t WS_MODP = 40 * MiB, WS_MODF = 41 * MiB, WS_CS = 41 * MiB + 512 * 1024, WS_PART = 42 * MiB;
constexpr size_t WS_HN = 48 * MiB;
constexpr size_t WS_Q = 80 * MiB, WS_K = 96 * MiB, WS_V = 112 * MiB, WS_SGA = 128 * MiB, WS_YG = 144 * MiB, WS_SGC = 160 * MiB;
constexpr size_t WS_O1 = 176 * MiB, WS_O2 = 192 * MiB, WS_CL = 208 * MiB;
constexpr size_t WS_MIX = 224 * MiB, WS_END = 256 * MiB;

constexpr int RING_BYTES = 131072;
constexpr int LDS_BYTES = 147456;
constexpr int MISC_OFF = RING_BYTES + 320;

#define LAS __attribute__((address_space(3)))
typedef unsigned short bf16;
#define GAS __attribute__((address_space(1)))
typedef unsigned v4u __attribute__((ext_vector_type(4)));
typedef unsigned v2u __attribute__((ext_vector_type(2)));
typedef float f32x4 __attribute__((ext_vector_type(4)));
typedef float f32x2 __attribute__((ext_vector_type(2)));

#define XB_TMO      128
#define XB_XCNT(j)  (256  + 64 * (j))
#define XB_XSUB(j)  (1280 + 64 * (j))
#define XB_XGEN(j)  (2304 + 64 * (j))
#define XB_TOP      3328
#define XB_TOPGEN   3392
#define XCD_BAR_WORDS 3456
#define XB_SPIN_CAP (1u << 18)

__device__ __forceinline__ unsigned xb_ld(unsigned* p)              { return __hip_atomic_load(p, __ATOMIC_RELAXED, __HIP_MEMORY_SCOPE_AGENT); }
__device__ __forceinline__ unsigned xb_add(unsigned* p, unsigned v) { return __hip_atomic_fetch_add(p, v, __ATOMIC_RELAXED, __HIP_MEMORY_SCOPE_AGENT); }
__device__ __forceinline__ unsigned xb_xcc_id() { return (unsigned)__builtin_amdgcn_s_getreg((3 << 11) | 20) & 0xFu; }
#define XB_SPIN(cond, bar) do { unsigned _sp = 0; while (cond) { __builtin_amdgcn_s_sleep(1); \
    if ((++_sp & 255u) == 0u) { if (xb_ld(&(bar)[XB_TMO])) break; if (_sp > XB_SPIN_CAP) { atomicAdd(&(bar)[XB_TMO], 1u); break; } } } } while (0)

struct XcdBarrier {
    unsigned* bar; unsigned x;
    volatile LAS unsigned* st;
};

__device__ __forceinline__ XcdBarrier xcd_barrier_post(unsigned* bar, volatile LAS unsigned* st) {
    XcdBarrier b; b.bar = bar; b.x = xb_xcc_id(); b.st = st;
    if (threadIdx.x == 0) (void)xb_add(&bar[XB_XCNT(b.x)], 1u);
    return b;
}
__device__ __forceinline__ void xcd_barrier_complete(unsigned* bar, unsigned x, unsigned& nloc, unsigned& nx) {
    const unsigned G = gridDim.x * gridDim.y * gridDim.z;
    unsigned sum, cnt, mine, sp = 0u;
    for (;;) {
        sum = 0u; cnt = 0u; mine = 0u;
#pragma unroll
        for (unsigned j = 0; j < 16; ++j) { const unsigned c = xb_ld(&bar[XB_XCNT(j)]); sum += c; cnt += (c > 0u) ? 1u : 0u; mine = (j == x) ? c : mine; }
        if (sum == G) break;
        __builtin_amdgcn_s_sleep(1);
        if ((++sp & 255u) == 0u) { if (xb_ld(&bar[XB_TMO])) break; if (sp > XB_SPIN_CAP) { atomicAdd(&bar[XB_TMO], 1u); break; } }
    }
    nloc = mine > 0u ? mine : 1u; nx = cnt > 0u ? cnt : 1u;
}

__device__ __forceinline__ void xcd_barrier(const XcdBarrier& b) {
    asm volatile("s_waitcnt vmcnt(0)" ::: "memory");
    __syncthreads();
    if (threadIdx.x == 0) {
        unsigned* bar = b.bar;
        __builtin_amdgcn_s_waitcnt(0);
        unsigned nloc = b.st[0], nx = b.st[1];
        if (nloc == 0u) { xcd_barrier_complete(bar, b.x, nloc, nx); b.st[0] = nloc; b.st[1] = nx; }
        const unsigned old = xb_add(&bar[XB_XSUB(b.x)], 1u);
        const unsigned gen = old / nloc;
        if (old + 1u == (gen + 1u) * nloc) {
            __builtin_amdgcn_fence(__ATOMIC_RELEASE, "agent");
            asm volatile("s_waitcnt vmcnt(0)" ::: "memory");
            const unsigned og = xb_add(&bar[XB_TOP], 1u);
            const unsigned tg = og / nx;
            if (og + 1u == (tg + 1u) * nx) xb_add(&bar[XB_TOPGEN], 1u);
            else XB_SPIN(xb_ld(&bar[XB_TOPGEN]) == tg, bar);
            __builtin_amdgcn_fence(__ATOMIC_ACQUIRE, "agent");
            xb_add(&bar[XB_XGEN(b.x)], 1u);
            asm volatile("s_waitcnt vmcnt(0)" ::: "memory");
        } else {
            XB_SPIN(xb_ld(&bar[XB_XGEN(b.x)]) == gen, bar);
            __builtin_amdgcn_fence(__ATOMIC_ACQUIRE, "agent");
            asm volatile("s_waitcnt vmcnt(0)" ::: "memory");
        }
    }
    __syncthreads();
}

__device__ __forceinline__ float wave_sum(float v) {
#pragma unroll
    for (int o = 1; o < 64; o <<= 1) v += __shfl_xor(v, o);
    return v;
}
__device__ __forceinline__ unsigned pk2(float lo, float hi) { return pg8::cvt_pk_bf16(lo, hi); }
__device__ __forceinline__ float silu_f(float x) { return x * __builtin_amdgcn_rcpf(1.0f + __expf(-x)); }

__device__ __forceinline__ int win_dest_row(int n0) {
    if (n0 < 4096 || n0 >= 6144) return n0;
    if (n0 < 5120) { const int a = n0 - 4096; return 4096 + (a >> 7) * 256 + (a & 127); }
    const int a = n0 - 5120; return 4096 + (a >> 7) * 256 + 128 + (a & 127);
}
__device__ __forceinline__ void p0_transpose_item(const float* W, int K, int N, bf16* WT, bool remap, LAS float* scr, int item, int lane) {
    const int nblk = N / 32, kb = item / nblk, nb = item % nblk, k0 = 64 * kb, n0 = 32 * nb;
    const int d0 = remap ? win_dest_row(n0) : n0;
    { const int r = lane >> 3, q = lane & 7; f32x4 v[8];
#pragma unroll
      for (int i = 0; i < 8; ++i) v[i] = __builtin_nontemporal_load((const __attribute__((address_space(1))) f32x4*)(W + (size_t)(k0 + 8 * i + r) * N + n0 + 4 * q));
#pragma unroll
      for (int i = 0; i < 8; ++i) { LAS float* d = scr + (8 * i + r) * 33 + 4 * q; d[0] = v[i].x; d[1] = v[i].y; d[2] = v[i].z; d[3] = v[i].w; } }
    asm volatile("s_waitcnt lgkmcnt(0)" ::: "memory");
    const int c = lane & 7;
#pragma unroll
    for (int j = 0; j < 4; ++j) { const int n = (lane >> 3) + 8 * j; const LAS float* s = scr + (8 * c) * 33 + n;
        v4u o; o.x = pk2(s[0 * 33], s[1 * 33]); o.y = pk2(s[2 * 33], s[3 * 33]); o.z = pk2(s[4 * 33], s[5 * 33]); o.w = pk2(s[6 * 33], s[7 * 33]);
        *(v4u*)(WT + (size_t)(d0 + n) * K + k0 + 8 * c) = o; }
    asm volatile("s_waitcnt lgkmcnt(0)" ::: "memory");
}
__device__ __forceinline__ void p0_transpose_two(const float* W, int K, int N, bf16* WT, LAS float* scr, int itemA, int itemB, int lane) {
    const int nblk = N / 32, r = lane >> 3, q = lane & 7, c = lane & 7;
    const int kA = 64 * (itemA / nblk), nA = 32 * (itemA % nblk), kB = 64 * (itemB / nblk), nB = 32 * (itemB % nblk);
    f32x4 va[8], vb[8];
#pragma unroll
    for (int i = 0; i < 8; ++i) va[i] = __builtin_nontemporal_load((const __attribute__((address_space(1))) f32x4*)(W + (size_t)(kA + 8 * i + r) * N + nA + 4 * q));
#pragma unroll
    for (int i = 0; i < 8; ++i) vb[i] = __builtin_nontemporal_load((const __attribute__((address_space(1))) f32x4*)(W + (size_t)(kB + 8 * i + r) * N + nB + 4 * q));
#pragma unroll
    for (int h = 0; h < 2; ++h) { const int k0 = h ? kB : kA, n0 = h ? nB : nA;
#pragma unroll
        for (int i = 0; i < 8; ++i) { const f32x4 v = h ? vb[i] : va[i]; LAS float* d = scr + (8 * i + r) * 33 + 4 * q; d[0] = v.x; d[1] = v.y; d[2] = v.z; d[3] = v.w; }
        asm volatile("s_waitcnt lgkmcnt(0)" ::: "memory");
#pragma unroll
        for (int j = 0; j < 4; ++j) { const int n = (lane >> 3) + 8 * j; const LAS float* sp = scr + (8 * c) * 33 + n;
            v4u o; o.x = pk2(sp[0 * 33], sp[1 * 33]); o.y = pk2(sp[2 * 33], sp[3 * 33]); o.z = pk2(sp[4 * 33], sp[5 * 33]); o.w = pk2(sp[6 * 33], sp[7 * 33]);
            *(v4u*)(WT + (size_t)(n0 + n) * K + k0 + 8 * c) = o; }
        asm volatile("s_waitcnt lgkmcnt(0)" ::: "memory"); }
}
__device__ __forceinline__ float rope_invf(int i) {
    return i == 0 ? 1.0f : i == 1 ? 0x1.8d275ep-3f : i == 2 ? 0x1.341190p-5f : i == 3 ? 0x1.ddee9cp-8f : i == 4 ? 0x1.72ba44p-10f : i == 5 ? 0x1.1f91f0p-12f : i == 6 ? 0x1.be218ap-15f : 0x1.5a0f50p-17f;
}

template <int R> struct ConvRow {
    static __device__ __forceinline__ void run(f32x2 (&a)[32], const f32x2 (&w)[31], const LAS unsigned* lyu, int tid) {
        const unsigned p = lyu[R * 512 + tid]; const f32x2 y = (f32x2){__uint_as_float(p << 16), __uint_as_float(p & 0xffff0000u)};
#pragma unroll
        for (int t = (R > 30 ? R - 30 : 0); t <= (R < 31 ? R : 31); ++t) a[t] += w[R - t] * y;
        if ((R & 7) == 7) asm volatile("" ::: "memory");
        ConvRow<R + 1>::run(a, w, lyu, tid);
    }
};
template <> struct ConvRow<62> { static __device__ __forceinline__ void run(f32x2 (&)[32], const f32x2 (&)[31], const LAS unsigned*, int) {} };

__device__ __forceinline__ void gemv_item(const float* cvec, const float* w_ada, float* MODP, LAS unsigned char* L, int nchunk, int ks, int tid, int lane, int wave) {
    const int k0 = ks * 256 + wave * 32, n0 = nchunk * 256 + lane * 4;
    float ca0 = 0.f, ca1 = 0.f;
    if (lane < 32) { const float c0 = cvec[k0 + lane], c1 = cvec[2048 + k0 + lane]; ca0 = c0 / (1.0f + expf(-c0)); ca1 = c1 / (1.0f + expf(-c1)); }
    f32x4 a0 = {0.f, 0.f, 0.f, 0.f}, a1 = a0;
#pragma unroll
    for (int r = 0; r < 32; ++r) { const f32x4 w = __builtin_nontemporal_load((const __attribute__((address_space(1))) f32x4*)(w_ada + (size_t)(k0 + r) * 6144 + n0));
        const float s0 = __shfl(ca0, r), s1 = __shfl(ca1, r); a0 += s0 * w; a1 += s1 * w; }
    LAS f32x4* red = (LAS f32x4*)L;
    red[(wave * 2 + 0) * 64 + lane] = a0; red[(wave * 2 + 1) * 64 + lane] = a1;
    __syncthreads();
    { const int b = tid >> 8, col = tid & 255; const LAS float* rf = (const LAS float*)L; float s = 0.f;
#pragma unroll
      for (int w = 0; w < 8; ++w) s += rf[(w * 2 + b) * 256 + col];
      MODP[(size_t)(ks * 2 + b) * 6144 + nchunk * 256 + col] = s; }
    __syncthreads();
}

struct Args { const void* in[20]; float* out; unsigned char* ws; int ph_lo, ph_hi; };

#define WSL(var) unsigned char* var = args.ws; asm volatile("" : "+s"(var))
#define SMALLP(wsl, off) ((const float*)((wsl) + WS_SMALL) + (off))

__global__ void __launch_bounds__(NWAVES * 64, 2) mk_fwd(Args args) {
    extern __shared__ __attribute__((aligned(16))) unsigned char lds[];
    const int tid = threadIdx.x, wave = __builtin_amdgcn_readfirstlane(tid >> 6);
    const int G = gridDim.x, bx = blockIdx.x;
#define PHASE_LANE int lane_ = tid & 63; asm volatile("" : "+v"(lane_)); const int lane = lane_
    LAS unsigned char* L = (LAS unsigned char*)lds;
    const int lo = args.ph_lo, hi = args.ph_hi;
#define IN(k) (lo <= (k) && (k) < hi)
#define SEAM(k) do { if (IN(k) && IN((k) + 1)) xcd_barrier(bar); } while (0)
    for (int u = tid; u < (LDS_BYTES - RING_BYTES) / 4; u += NWAVES * 64) ((LAS unsigned*)(L + RING_BYTES))[u] = 0u;
    __syncthreads();
    XcdBarrier bar; bar.bar = (unsigned*)(args.ws + WS_CTL); bar.x = 0; bar.st = nullptr;
    if (hi - lo > 1) bar = xcd_barrier_post((unsigned*)(args.ws + WS_CTL), (volatile LAS unsigned*)(L + MISC_OFF) + 8);

    if (IN(0)) for (int rep_ = 0; rep_ < REP[0]; ++rep_) {
        WSL(wsl);
        PHASE_LANE;
        const float* cvec = (const float*)args.in[1]; const int* pos = (const int*)args.in[2]; const float* w_ada = (const float*)args.in[4];
        const float* w_in = (const float*)args.in[6]; const float* w_pw = (const float*)args.in[16]; const float* w_out = (const float*)args.in[18];
        bf16* WIN_T = (bf16*)(wsl + WS_WIN); bf16* WOUT_T = (bf16*)(wsl + WS_WOUT); bf16* WPW_T = (bf16*)(wsl + WS_WPW);
        float* MODP = (float*)(wsl + WS_MODP); float* CS = (float*)(wsl + WS_CS); float* SM = (float*)(wsl + WS_SMALL);
        const int vcu = (G % 8 == 0) ? (bx % 8) * (G / 8) + bx / 8 : bx;
        { const int gt = bx * 512 + tid, GT = G * 512;
          { const int e = (G * 512 - 1) - gt;
            if (e < S_END) { const float* src; int o;
              if (e < S_SUBLN) { src = (const float*)args.in[7 + (e >> 6)]; o = e & 63; }
              else if (e < S_DWB) { src = (const float*)args.in[11]; o = e - S_SUBLN; }
              else if (e < S_LNG) { src = (const float*)args.in[13]; o = e - S_DWB; }
              else if (e < S_LNB) { src = (const float*)args.in[14]; o = e - S_LNG; }
              else if (e < S_BPW) { src = (const float*)args.in[15]; o = e - S_LNB; }
              else if (e < S_FG) { src = (const float*)args.in[17]; o = e - S_BPW; }
              else if (e < S_NG) { src = (const float*)args.in[19]; o = e - S_FG; }
              else if (e < S_BADA) { src = (const float*)args.in[3]; o = e - S_NG; }
              else if (e < S_DWW) { src = (const float*)args.in[5]; o = e - S_BADA; }
              else { src = (const float*)args.in[12]; o = e - S_DWW; }
              SM[e] = src[o]; } }
        }
        if (bx == 0 && tid == 0) { const void** pp = (const void**)(wsl + WS_PTRS); pp[0] = args.in[1]; pp[1] = args.in[4]; pp[2] = args.in[18]; }
        for (int item = bx; item < 128; item += G) gemv_item(cvec, w_ada, MODP, L, item % 16, item / 16, tid, lane, wave);
        { LAS float* scr = (LAS float*)(L + wave * 16384);
          const int gw = vcu * NWAVES + wave, NGW = G * NWAVES;
          constexpr int I_IN = 32 * 224, I_PW = 16 * 32;
          const int NPRE = (G == 256) ? 3072 : 0;
          for (int q = 0; q < 3 + (I_IN + I_PW - NPRE + NGW - 1) / NGW; ++q) {
              int it;
              if (q < 3) { if (NPRE == 0 || bx < 128) continue; it = ((bx - 128) * NWAVES + wave) + 1024 * q; }
              else { it = NPRE + gw + (q - 3) * NGW; if (it >= I_IN + I_PW) break; }
              int r = it;
              if (r < I_IN) { p0_transpose_item(w_in, 2048, DIN, WIN_T, true, scr, r, lane); continue; } r -= I_IN;
              p0_transpose_item(w_pw, 1024, 1024, WPW_T, false, scr, r, lane);
          } }
        for (int idx = bx * 512 + tid; idx < M * 8; idx += G * 512) { const int m = idx >> 3, i = idx & 7;
            const float ang = (float)pos[m] * rope_invf(i);
            const double a = (double)ang * 0.15915494309189535; const float f = (float)(a - rint(a));
            CS[(size_t)m * 16 + i] = __builtin_amdgcn_cosf(f); CS[(size_t)m * 16 + 8 + i] = __builtin_amdgcn_sinf(f); }
        __syncthreads();
    }
    SEAM(0);

    if (IN(1)) for (int rep_ = 0; rep_ < REP[1]; ++rep_) {
        WSL(wsl);
        PHASE_LANE;
        const float* x = (const float*)args.in[0]; const float* b_ada = SMALLP(wsl, S_BADA); const float* norm_g = SMALLP(wsl, S_NG);
        const float* MODP = (const float*)(wsl + WS_MODP); float* MODF = (float*)(wsl + WS_MODF); bf16* HN = (bf16*)(wsl + WS_HN);
        LAS float* tabA = (LAS float*)L; LAS float* tabB = tabA + 2048;
        for (int rb = bx; rb < M / 32; rb += G) {
            const int b = (rb * 32) / SEQ;
#pragma unroll
            for (int k = tid; k < 2048; k += 512) { float sh = b_ada[k], sc = b_ada[2048 + k];
#pragma unroll
                for (int ks = 0; ks < 8; ++ks) { sh += MODP[(size_t)(ks * 2 + b) * 6144 + k]; sc += MODP[(size_t)(ks * 2 + b) * 6144 + 2048 + k]; }
                tabA[k] = norm_g[k] * (1.0f + sc); tabB[k] = sh; }
            __syncthreads();
#pragma unroll 1
            for (int rr = 0; rr < 4; rr += 2) { const int m = rb * 32 + wave * 4 + rr;
                const f32x4* xr0 = (const f32x4*)(x + (size_t)m * DM) + lane; const f32x4* xr1 = xr0 + DM / 4; f32x4 v0[8], v1[8]; float s0 = 0.f, s1 = 0.f;
#pragma unroll
                for (int j = 0; j < 8; ++j) { v0[j] = __builtin_nontemporal_load((const __attribute__((address_space(1))) f32x4*)(xr0 + 64 * j)); v1[j] = __builtin_nontemporal_load((const __attribute__((address_space(1))) f32x4*)(xr1 + 64 * j)); }
#pragma unroll
                for (int j = 0; j < 8; ++j) { s0 += (v0[j].x * v0[j].x + v0[j].y * v0[j].y) + (v0[j].z * v0[j].z + v0[j].w * v0[j].w);
                                              s1 += (v1[j].x * v1[j].x + v1[j].y * v1[j].y) + (v1[j].z * v1[j].z + v1[j].w * v1[j].w); }
                const float rstd0 = 1.0f / sqrtf(wave_sum(s0) * (1.0f / DM) + EPS), rstd1 = 1.0f / sqrtf(wave_sum(s1) * (1.0f / DM) + EPS);
                v2u* o8 = (v2u*)(HN + (size_t)m * DM) + lane;
#pragma unroll
                for (int j = 0; j < 8; ++j) { const f32x4 A = *(const LAS f32x4*)(tabA + 4 * lane + 256 * j), B = *(const LAS f32x4*)(tabB + 4 * lane + 256 * j);
                    const f32x4 h0 = v0[j] * rstd0 * A + B, h1 = v1[j] * rstd1 * A + B; v2u w0, w1; w0.x = pk2(h0.x, h0.y); w0.y = pk2(h0.z, h0.w); w1.x = pk2(h1.x, h1.y); w1.y = pk2(h1.z, h1.w);
                    o8[64 * j] = w0; o8[DM / 4 + 64 * j] = w1; } }
            __syncthreads();
        }
    }
    SEAM(1);

    if (IN(2)) for (int rep_ = 0; rep_ < REP[2]; ++rep_) {
        WSL(wsl);
        bf16* HN = (bf16*)(wsl + WS_HN); bf16* WIN_T = (bf16*)(wsl + WS_WIN); bf16* QB = (bf16*)(wsl + WS_Q); bf16* KB = (bf16*)(wsl + WS_K); bf16* VB = (bf16*)(wsl + WS_V);
        bf16* SGA = (bf16*)(wsl + WS_SGA); bf16* YG = (bf16*)(wsl + WS_YG); bf16* SGC = (bf16*)(wsl + WS_SGC); const float* CS = (const float*)(wsl + WS_CS);
        pg8::Gemm g{HN, WIN_T, M, DIN, DM}; pg8::OrderSkipGA S; S.o.init(M, DIN - 1024, G, bx);
        pg8::EpiIn E{QB, KB, VB, SGA, YG, SGC, CS, attn_body::C2};
        pg8::gemm_phase<pg8::EpiIn, pg8::OrderSkipGA, PG8_ALIGN, PG8_SP2>(L, g, S, E);
    }
    SEAM(2);

    if (IN(3)) for (int rep_ = 0; rep_ < REP[3]; ++rep_) {
        WSL(wsl);
        PHASE_LANE;
        const bf16* YG = (const bf16*)(wsl + WS_YG); bf16* CL = (bf16*)(wsl + WS_CL);
        const float* dw_w = SMALLP(wsl, S_DWW); const float* dw_b = SMALLP(wsl, S_DWB); const float* ln_g = SMALLP(wsl, S_LNG); const float* ln_b = SMALLP(wsl, S_LNB);
        for (int tb = bx; tb < M / 32; tb += G) {
            const int m0 = tb * 32, t0 = m0 % SEQ;
            LAS v4u* ly = (LAS v4u*)L;
            { v4u sv[16];
#pragma unroll
              for (int i = 0; i < 16; ++i) { const int ch = tid + 512 * i, r = ch >> 7, cc = ch & 127; sv[i] = (v4u){0u, 0u, 0u, 0u};
                  if (ch < 62 * 128 && t0 - 30 + r >= 0) sv[i] = *(const v4u*)(YG + (size_t)(m0 - 30 + r) * 1024 + cc * 8); }
              f32x2 w[31];
#pragma unroll
              for (int j = 0; j < 31; ++j) w[j] = *(const f32x2*)(dw_w + j * 1024 + 2 * tid);
#pragma unroll
              for (int i = 0; i < 16; ++i) { const int ch = tid + 512 * i; if (ch < 62 * 128) ly[ch] = sv[i]; }
              __syncthreads();
              const f32x2 bias = *(const f32x2*)(dw_b + 2 * tid);
              const LAS unsigned* lyu = (const LAS unsigned*)L;
              f32x2 a[32];
#pragma unroll
              for (int t = 0; t < 32; ++t) a[t] = bias;
              ConvRow<0>::run(a, w, lyu, tid);
              float v[64];
#pragma unroll
              for (int t = 0; t < 32; ++t) { v[t] = a[t].x + a[t].y; v[32 + t] = a[t].x * a[t].x + a[t].y * a[t].y; }
#define BSTEP(h) { const bool up = (lane & (h)) != 0; _Pragma("unroll") for (int i = 0; i < (h); ++i) { const float snd = up ? v[i] : v[i + (h)], keep = up ? v[i + (h)] : v[i]; v[i] = keep + __shfl_xor(snd, (h)); } }
              BSTEP(32) BSTEP(16) BSTEP(8) BSTEP(4) BSTEP(2) BSTEP(1)
#undef BSTEP
              LAS float* red = (LAS float*)(L + 62 * 2048);
              red[wave * 64 + lane] = v[0];
              __syncthreads();
              if (tid < 32) { float sm = 0.f, q = 0.f;
#pragma unroll
                  for (int wv = 0; wv < 8; ++wv) { sm += red[wv * 64 + tid]; q += red[wv * 64 + 32 + tid]; }
                  const float mean = sm * (1.0f / 1024.0f), var = q * (1.0f / 1024.0f) - mean * mean;
                  *(LAS f32x2*)(L + 62 * 2048 + 2048 + 8 * tid) = (f32x2){mean, 1.0f / sqrtf(var + EPS)}; }
              __syncthreads();
              const f32x2 lg = *(const f32x2*)(ln_g + 2 * tid), lb = *(const f32x2*)(ln_b + 2 * tid);
#pragma unroll
              for (int t = 0; t < 32; ++t) { const f32x2 st = *(const LAS f32x2*)(L + 62 * 2048 + 2048 + 8 * t);
                  const f32x2 o = (a[t] - st.x) * st.y * lg + lb;
                  *(unsigned*)(CL + (size_t)(m0 + t) * 1024 + 2 * tid) = pk2(silu_f(o.x), silu_f(o.y)); }
            }
            __syncthreads();
        }
        asm volatile("s_waitcnt vmcnt(0)" ::: "memory"); __syncthreads();
        if (tid == 0) { __builtin_amdgcn_fence(__ATOMIC_RELEASE, "agent"); asm volatile("s_waitcnt vmcnt(0)" ::: "memory");
            __hip_atomic_fetch_add((unsigned*)(wsl + WS_CTL) + CW_CONV, 1u, __ATOMIC_RELAXED, __HIP_MEMORY_SCOPE_AGENT); }
        WSL(wsa);
        const attn_body::AttnTensors AT{(const attn_body::bf16*)(wsa + WS_Q), (const attn_body::bf16*)(wsa + WS_K), (const attn_body::bf16*)(wsa + WS_V), (attn_body::bf16*)(wsa + WS_O1), (attn_body::bf16*)(wsa + WS_O2)};
        const attn_body::StaticOrder S(G, bx);
        attn_body::attn_phase<attn_body::StaticOrder>((char*)lds, AT, S);
        { WSL(wsg);
          const int vcu = (bx % 8) * (G / 8) + bx / 8, idx = (vcu >> 3) * 4 + (vcu & 3);
          if (G == 256 && (vcu & 4) == 0) {
              unsigned* cw = (unsigned*)(wsg + WS_CTL) + CW_CONV;
              if (wave == 0) { unsigned sp = 0;
                  for (;;) { if ((unsigned)__builtin_amdgcn_readfirstlane(__hip_atomic_load(cw, __ATOMIC_RELAXED, __HIP_MEMORY_SCOPE_AGENT)) >= (unsigned)G) break;
                      if (++sp > (1u << 22)) break; __builtin_amdgcn_s_sleep(2); }
                  __builtin_amdgcn_fence(__ATOMIC_ACQUIRE, "agent"); }
              asm volatile("s_waitcnt vmcnt(0) lgkmcnt(0)" ::: "memory"); __syncthreads();
              pg8::Gemm g{(const bf16*)(wsg + WS_CL), (const bf16*)(wsg + WS_WPW), M, 1024, 1024}; pg8::OrderOne S1{idx >> 2, idx & 3};
              pg8::EpiPw E{SMALLP(wsg, S_BPW), (const bf16*)(wsg + WS_SGC), (bf16*)(wsg + WS_MIX)};
              pg8::gemm_phase<pg8::EpiPw, pg8::OrderOne, false, PG8_SP2>(L, g, S1, E);
          } else if (G == 256) {
              pg8::Gemm g{(const bf16*)(wsg + WS_HN), (const bf16*)(wsg + WS_WIN), M, DIN, DM}; pg8::OrderGA S1{idx};
              pg8::EpiIn E{(bf16*)(wsg + WS_Q), (bf16*)(wsg + WS_K), (bf16*)(wsg + WS_V), (bf16*)(wsg + WS_SGA), (bf16*)(wsg + WS_YG), (bf16*)(wsg + WS_SGC), (const float*)(wsg + WS_CS), attn_body::C2};
              pg8::gemm_phase<pg8::EpiIn, pg8::OrderGA, false, PG8_SP2>(L, g, S1, E);
              const int lane = tid & 63;
              const float* cvec = (const float*)((const void* const*)(wsg + WS_PTRS))[0]; const float* w_ada = (const float*)((const void* const*)(wsg + WS_PTRS))[1]; const float* w_out = (const float*)((const void* const*)(wsg + WS_PTRS))[2];
              { LAS float* scr = (LAS float*)(L + wave * 16384);
                p0_transpose_two(w_out, 2048, 2048, (bf16*)(wsg + WS_WOUT), scr, idx * NWAVES + wave, idx * NWAVES + wave + 128 * NWAVES, lane); }
              __syncthreads();
              if (idx < 64) gemv_item(cvec, w_ada, (float*)(wsg + WS_MODP), L, 16 + (idx & 7), idx >> 3, tid, lane, wave);
          } }
    }
    SEAM(3);

    if (IN(4)) for (int rep_ = 0; rep_ < REP[4]; ++rep_) {
        WSL(wsl);
        PHASE_LANE;
        bf16* MIX = (bf16*)(wsl + WS_MIX);
        const bf16* O1 = (const bf16*)(wsl + WS_O1); const bf16* O2 = (const bf16*)(wsl + WS_O2); const bf16* SGA = (const bf16*)(wsl + WS_SGA);
        const float* lamv = SMALLP(wsl, S_LAM); const float* subln_g = SMALLP(wsl, S_SUBLN);
        { const float* b_ada = SMALLP(wsl, S_BADA); const float* MODP = (const float*)(wsl + WS_MODP); float* MODF = (float*)(wsl + WS_MODF);
          for (int idx = bx * 512 + tid; idx < 2 * 2048; idx += G * 512) { const int b = idx >> 11, n = 4096 + (idx & 2047); float sgt = b_ada[n];
#pragma unroll
              for (int ks = 0; ks < 8; ++ks) sgt += MODP[(size_t)(ks * 2 + b) * 6144 + n];
              MODF[b * 6144 + n] = sgt; } }
        const float lam = expf(wave_sum(lamv[lane] * lamv[64 + lane])) - expf(wave_sum(lamv[128 + lane] * lamv[192 + lane])) + 0.2f;
        f32x4 sg[4];
#pragma unroll
        for (int i = 0; i < 4; ++i) sg[i] = *(const f32x4*)(subln_g + 16 * (lane & 7) + 4 * i) * 0.8f;
#pragma unroll 4
        for (int m = bx * NWAVES + wave; m < M; m += G * NWAVES) {
            const size_t off = (size_t)m * 1024 + 16 * lane;
#define NTL(p) __builtin_nontemporal_load((const __attribute__((address_space(1))) v4u*)(p))
            const v4u a0 = NTL(O1 + off), a1 = NTL(O1 + off + 8), b0 = NTL(O2 + off), b1 = NTL(O2 + off + 8);
            const v4u g0 = NTL(SGA + off), g1 = NTL(SGA + off + 8);
#undef NTL
            f32x4 o[4];
            o[0] = pg8::bf_lo4(a0.x, a0.y) - lam * pg8::bf_lo4(b0.x, b0.y); o[1] = pg8::bf_lo4(a0.z, a0.w) - lam * pg8::bf_lo4(b0.z, b0.w);
            o[2] = pg8::bf_lo4(a1.x, a1.y) - lam * pg8::bf_lo4(b1.x, b1.y); o[3] = pg8::bf_lo4(a1.z, a1.w) - lam * pg8::bf_lo4(b1.z, b1.w);
            float ss = 0.f;
#pragma unroll
            for (int i = 0; i < 4; ++i) ss += (o[i].x * o[i].x + o[i].y * o[i].y) + (o[i].z * o[i].z + o[i].w * o[i].w);
            ss += __shfl_xor(ss, 1); ss += __shfl_xor(ss, 2); ss += __shfl_xor(ss, 4);
            const float rs = 1.0f / sqrtf(ss * (1.0f / 128.0f) + EPS);
            const f32x4 y0 = o[0] * rs * sg[0] * pg8::bf_lo4(g0.x, g0.y), y1 = o[1] * rs * sg[1] * pg8::bf_lo4(g0.z, g0.w);
            const f32x4 y2 = o[2] * rs * sg[2] * pg8::bf_lo4(g1.x, g1.y), y3 = o[3] * rs * sg[3] * pg8::bf_lo4(g1.z, g1.w);
            bf16* dst = MIX + (size_t)m * 2048 + 16 * lane;
            pg8::store8(dst, y0, y1); pg8::store8(dst + 8, y2, y3);
        }
    }
    SEAM(4);

    if (IN(5)) for (int rep_ = 0; rep_ < REP[5]; ++rep_) {
        WSL(wsl);
        const float* x = (const float*)args.in[0]; float* out = args.out;
        bf16* MIX = (bf16*)(wsl + WS_MIX); bf16* WOUT_T = (bf16*)(wsl + WS_WOUT); const float* MODF = (const float*)(wsl + WS_MODF);
        pg8::Gemm g{MIX, WOUT_T, M, 2048, 2048}; pg8::StaticOrder S; S.init(M, 2048, G, bx);
        pg8::EpiOutNorm E{x, MODF, SMALLP(wsl, S_FG), out, (unsigned*)(wsl + WS_PART), (unsigned*)(wsl + WS_CTL) + CW_PANEL, EPS};
        pg8::gemm_phase<pg8::EpiOutNorm, pg8::StaticOrder, false, PG8_SP2>(L, g, S, E);
    }
#undef IN
#undef SEAM
}

extern "C" void kernel_launch(void* const* d_in, const int* in_sizes, int n_in, void* d_out, int out_size, void* d_ws, size_t ws_size, hipStream_t stream) {
    static int grid = 0;
    if (grid == 0) {
        if (n_in != 20 || out_size != M * DM || ws_size < WS_END) { fprintf(stderr, "kernel_launch: unexpected shapes (n_in %d, out %d, ws %zu); nothing launched\n", n_in, out_size, ws_size); grid = -1; return; }
        int dev = 0, cus = 0, per_cu = 0;
        if (hipGetDevice(&dev) != hipSuccess || hipDeviceGetAttribute(&cus, hipDeviceAttributeMultiprocessorCount, dev) != hipSuccess) { grid = -1; return; }
        if (hipFuncSetAttribute((const void*)mk_fwd, hipFuncAttributeMaxDynamicSharedMemorySize, LDS_BYTES) != hipSuccess) { fprintf(stderr, "kernel_launch: hipFuncSetAttribute failed\n"); grid = -1; return; }
        if (hipOccupancyMaxActiveBlocksPerMultiprocessor(&per_cu, (const void*)mk_fwd, NWAVES * 64, LDS_BYTES) != hipSuccess || per_cu < 1) { fprintf(stderr, "kernel_launch: occupancy query says %d blocks per CU\n", per_cu); (void)hipGetLastError(); per_cu = 1; }
        grid = cus * 1;
        if (grid > 256) grid = 256;
    }
    if (grid < 0) return;
    if (hipMemsetAsync((char*)d_ws + WS_CTL, 0, CTL_ZERO_BYTES, stream) != hipSuccess) { fprintf(stderr, "kernel_launch: hipMemsetAsync failed\n"); return; }
    Args a{};
    for (int i = 0; i < 20; ++i) a.in[i] = d_in[i];
    a.out = (float*)d_out; a.ws = (unsigned char*)d_ws;
    if (N_LAUNCHES == 1) {
        a.ph_lo = 0; a.ph_hi = N_PHASES;
        void* kargs[] = {&a};
        hipError_t e = hipLaunchCooperativeKernel((const void*)mk_fwd, dim3(grid), dim3(NWAVES * 64), kargs, LDS_BYTES, stream);
        if (e != hipSuccess) fprintf(stderr, "kernel_launch: cooperative launch failed: %s (grid %d)\n", hipGetErrorString(e), grid);
    } else {
        for (int p = 0; p < N_PHASES; ++p) { a.ph_lo = p; a.ph_hi = p + 1;
            hipLaunchKernelGGL(mk_fwd, dim3(grid), dim3(NWAVES * 64), LDS_BYTES, stream, a); }
    }
}
```

```cpp
#include <hip/hip_runtime.h>
#include <cstdio>
#include <cstdint>
namespace pg8 {
#define PG8_LAS __attribute__((address_space(3)))
typedef unsigned short bf16_t;
typedef short bf16x8 __attribute__((ext_vector_type(8)));
typedef float f32x4 __attribute__((ext_vector_type(4)));
typedef unsigned u32x4 __attribute__((ext_vector_type(4)));
constexpr int BM = 256, BK = 64, HALF = 128, HTB = HALF * BK * 2  , STAGE_BYTES = 8 * HTB, NXCD = 8, WGM = 8;

__host__ __device__ __forceinline__ int lds_byte(int r, int c) { const int st = (r >> 4) * 2 + (c >> 5), rr = r & 15, cc = c & 31, ob = rr * 64 + cc * 2; return st * 1024 + (ob ^ (((ob >> 9) & 1) << 5)); }
__host__ __device__ __forceinline__ void stage_rc(int b, int& R, int& C) { const int st = b / 1024, sb = b % 1024, swz = sb ^ (((sb >> 9) & 1) << 5); R = (st >> 1) * 16 + swz / 64; C = (st & 1) * 32 + (swz % 64) / 2; }
__host__ __device__ __forceinline__ int perm32(int rho) { const int n = rho >> 4, i = rho & 15; return 8 * (i >> 2) + 4 * n + (i & 3); }

struct Unit { int pm, pn; };
struct Gemm { const bf16_t* A; const bf16_t* Bt; int M, N, K; };

struct StaticOrder {
    int nM, nN, nwg, G, c, wgm;
    __host__ __device__ void init(int M, int N, int G_, int c_) { nM = M / BM; nN = N / BM; nwg = nM * nN; G = G_; c = c_; wgm = WGM; }
    __host__ __device__ bool next(int i, Unit& u) const {
        const long L = (long)i * G + c; if (L >= nwg) return false;
        int wgid = (int)L; { const int q = nwg / NXCD, r = nwg % NXCD, xcd = wgid % NXCD, off = wgid / NXCD; wgid = (xcd < r ? xcd * (q + 1) : r * (q + 1) + (xcd - r) * q) + off; }
        const int nig = wgm * nN, gid = wgid / nig, fm = gid * wgm, gsz = (nM - fm) < wgm ? (nM - fm) : wgm;
        u.pm = fm + ((wgid % nig) % gsz); u.pn = (wgid % nig) / gsz; return true;
    }
    __device__ __forceinline__ void a_ready(const Unit&) const {}
    __device__ __forceinline__ void done(const Unit&) const {}
};

__device__ __forceinline__ unsigned cvt_pk_bf16(float lo, float hi) { unsigned r; asm volatile("v_cvt_pk_bf16_f32 %0, %1, %2" : "=v"(r) : "v"(lo), "v"(hi)); return r; }
__device__ __forceinline__ float fast_sigmoid(float x) { return __builtin_amdgcn_rcpf(1.0f + __expf(-x)); }
__device__ __forceinline__ float fast_silu(float x) { return x * fast_sigmoid(x); }
__device__ __forceinline__ void store8(bf16_t* p, f32x4 v0, f32x4 v1) {
    u32x4 w; w.x = cvt_pk_bf16(v0[0], v0[1]); w.y = cvt_pk_bf16(v0[2], v0[3]); w.z = cvt_pk_bf16(v1[0], v1[1]); w.w = cvt_pk_bf16(v1[2], v1[3]);
    *(__attribute__((address_space(1))) u32x4*)p = w;
}
__device__ __forceinline__ f32x4 silu4(f32x4 v) { return (f32x4){fast_silu(v[0]), fast_silu(v[1]), fast_silu(v[2]), fast_silu(v[3])}; }
__device__ __forceinline__ f32x4 sig4(f32x4 v) { return (f32x4){fast_sigmoid(v[0]), fast_sigmoid(v[1]), fast_sigmoid(v[2]), fast_sigmoid(v[3])}; }
__device__ __forceinline__ f32x4 bf_lo4(unsigned a, unsigned b) { return (f32x4){__uint_as_float(a << 16), __uint_as_float(a & 0xffff0000u), __uint_as_float(b << 16), __uint_as_float(b & 0xffff0000u)}; }

struct EpiIn {
    static constexpr bool PERM = true, AFTER_DRAIN = false;
    bf16_t *Q, *K, *V, *SGA, *YG, *SGC; const float* cs; float qscale;
    __device__ __forceinline__ void operator()(const f32x4 (&acc)[2][2][4][2], const Unit& u, int wr, int wc, int fr, int fq) const {
        const int pn = u.pn; const int row0 = u.pm * BM + wr * 64 + fr; const int cw = wc * 32 + 8 * fq;
        if (pn < 8) {
            bf16_t* base = (pn < 4 ? Q : K) + (pn & 3) * 256 + cw; const float sc = pn < 4 ? qscale : 1.f;
            const bool rot = ((wc & 1) == 0); const float sgn = fq == 0 ? -1.f : 1.f; const bool act = fq < 2;
#pragma unroll
            for (int ai = 0; ai < 2; ++ai) { f32x4 csv[4][4];
                if (rot) {
#pragma unroll
                    for (int m = 0; m < 4; ++m)
#pragma unroll
                        for (int k = 0; k < 4; ++k) csv[m][k] = *((const __attribute__((address_space(1))) f32x4*)(cs + (size_t)(row0 + ai * HALF + m * 16) * 16) + k); }
#pragma unroll
                for (int m = 0; m < 4; ++m) { const int row = row0 + ai * HALF + m * 16;
                    f32x4 c0 = {1.f, 1.f, 1.f, 1.f}, c1 = c0, s0 = {0.f, 0.f, 0.f, 0.f}, s1 = s0;
                    if (rot) { c0 = csv[m][0]; c1 = csv[m][1]; s0 = csv[m][2]; s1 = csv[m][3]; }
#pragma unroll
                    for (int bj = 0; bj < 2; ++bj) { f32x4 v0 = acc[ai][bj][m][0], v1 = acc[ai][bj][m][1];
                        if (rot) { f32x4 p0, p1;
#pragma unroll
                            for (int j = 0; j < 4; ++j) { p0[j] = __shfl_xor(v0[j], 16); p1[j] = __shfl_xor(v1[j], 16); }
                            if (act) { v0 = v0 * c0 + sgn * (p0 * s0); v1 = v1 * c1 + sgn * (p1 * s1); } }
                        v0 = v0 * sc; v1 = v1 * sc; store8(base + (size_t)row * 1024 + bj * HALF, v0, v1); } } }
        } else if (pn < 12) {
            bf16_t* base = V + (pn - 8) * 256 + cw;
#pragma unroll
            for (int ai = 0; ai < 2; ++ai)
#pragma unroll
                for (int m = 0; m < 4; ++m) { const int row = row0 + ai * HALF + m * 16;
#pragma unroll
                    for (int bj = 0; bj < 2; ++bj) store8(base + (size_t)row * 1024 + bj * HALF, acc[ai][bj][m][0], acc[ai][bj][m][1]); }
        } else if (pn < 16 || pn >= 24) {
            bf16_t* base = (pn < 16 ? SGA + (pn - 12) * 256 : SGC + (pn - 24) * 256) + cw;
#pragma unroll
            for (int ai = 0; ai < 2; ++ai)
#pragma unroll
                for (int m = 0; m < 4; ++m) { const int row = row0 + ai * HALF + m * 16;
#pragma unroll
                    for (int bj = 0; bj < 2; ++bj) store8(base + (size_t)row * 1024 + bj * HALF, silu4(acc[ai][bj][m][0]), silu4(acc[ai][bj][m][1])); }
        } else {
            bf16_t* base = YG + (pn - 16) * 128 + cw;
#pragma unroll
            for (int ai = 0; ai < 2; ++ai)
#pragma unroll
                for (int m = 0; m < 4; ++m) { const int row = row0 + ai * HALF + m * 16;
                    store8(base + (size_t)row * 1024, acc[ai][0][m][0] * sig4(acc[ai][1][m][0]), acc[ai][0][m][1] * sig4(acc[ai][1][m][1])); }
        }
    }
};
struct EpiPw {
    static constexpr bool PERM = true, AFTER_DRAIN = false;
    const float* bias; const bf16_t* SGC; bf16_t* MIX;
    __device__ __forceinline__ void operator()(const f32x4 (&acc)[2][2][4][2], const Unit& u, int wr, int wc, int fr, int fq) const {
        const int row0 = u.pm * BM + wr * 64 + fr; const int col0 = u.pn * BM + wc * 32 + 8 * fq;
        f32x4 bv[2][2];
#pragma unroll
        for (int bj = 0; bj < 2; ++bj)
#pragma unroll
            for (int n = 0; n < 2; ++n) bv[bj][n] = *(const f32x4*)(bias + col0 + bj * HALF + 4 * n);
#pragma unroll
        for (int ai = 0; ai < 2; ++ai) { u32x4 gq[4][2];
#pragma unroll
            for (int m = 0; m < 4; ++m)
#pragma unroll
                for (int bj = 0; bj < 2; ++bj) gq[m][bj] = *(const __attribute__((address_space(1))) u32x4*)(SGC + (size_t)(row0 + ai * HALF + m * 16) * 1024 + col0 + bj * HALF);
#pragma unroll
            for (int m = 0; m < 4; ++m) { const int row = row0 + ai * HALF + m * 16;
#pragma unroll
                for (int bj = 0; bj < 2; ++bj) { const u32x4 g = gq[m][bj];
                    const f32x4 v0 = (acc[ai][bj][m][0] + bv[bj][0]) * bf_lo4(g.x, g.y), v1 = (acc[ai][bj][m][1] + bv[bj][1]) * bf_lo4(g.z, g.w);
                    store8(MIX + (size_t)row * 2048 + 1024 + col0 + bj * HALF, v0, v1); } } }
    }
};
struct EpiOut {
    static constexpr bool PERM = true, AFTER_DRAIN = false;
    const float* x; const float* gate; float* out; float* part;
    __device__ __forceinline__ void operator()(const f32x4 (&acc)[2][2][4][2], const Unit& u, int wr, int wc, int fr, int fq) const {
        const int row0 = u.pm * BM + wr * 64 + fr; const int col0 = u.pn * BM + wc * 32 + 8 * fq;
        const float* gp = gate + (size_t)((u.pm * BM) / 4096) * 6144 + 4096 + col0;
        f32x4 gv[2][2];
#pragma unroll
        for (int bj = 0; bj < 2; ++bj)
#pragma unroll
            for (int n = 0; n < 2; ++n) gv[bj][n] = *(const f32x4*)(gp + bj * HALF + 4 * n);
#pragma unroll
        for (int ai = 0; ai < 2; ++ai)
#pragma unroll
            for (int m = 0; m < 4; ++m) { const int row = row0 + ai * HALF + m * 16; float s = 0.f;
#pragma unroll
                for (int bj = 0; bj < 2; ++bj)
#pragma unroll
                    for (int n = 0; n < 2; ++n) { const size_t off = (size_t)row * 2048 + col0 + bj * HALF + 4 * n;
                        const f32x4 v = *(const f32x4*)(x + off) + gv[bj][n] * acc[ai][bj][m][n];
                        *(f32x4*)(out + off) = v; s += (v[0] * v[0] + v[1] * v[1]) + (v[2] * v[2] + v[3] * v[3]); }
                s += __shfl_xor(s, 16); s += __shfl_xor(s, 32);
                if (fq == 0) part[(size_t)row * 32 + u.pn * 4 + wc] = s; }
    }
};


struct EpiOutNorm {
    static constexpr bool PERM = true, AFTER_DRAIN = true;
    const float* x; const float* gate; const float* fg; float* out; unsigned* xbuf; unsigned* cnt; float eps;
    __device__ __forceinline__ void fused(f32x4 (&acc)[2][2][4][2], const Unit& u, int wr, int wc, int fr, int fq, PG8_LAS unsigned char* lds, int wid, int lane) const {
        PG8_LAS float* P = (PG8_LAS float*)lds;
        PG8_LAS float* S = (PG8_LAS float*)(lds + 4096);
        const int col0 = u.pn * BM + wc * 32 + 8 * fq;
        const float* gp = gate + (size_t)((u.pm * BM) / 4096) * 6144 + 4096 + col0;
        f32x4 gv[2][2];
#pragma unroll
        for (int bj = 0; bj < 2; ++bj)
#pragma unroll
            for (int n = 0; n < 2; ++n) gv[bj][n] = *(const f32x4*)(gp + bj * HALF + 4 * n);
#pragma unroll
        for (int ai = 0; ai < 2; ++ai) { f32x4 xv[4][2][2];
#pragma unroll
            for (int m = 0; m < 4; ++m)
#pragma unroll
                for (int bj = 0; bj < 2; ++bj)
#pragma unroll
                    for (int n = 0; n < 2; ++n) xv[m][bj][n] = __builtin_nontemporal_load((const __attribute__((address_space(1))) f32x4*)(x + (size_t)(u.pm * BM + ai * HALF + wr * 64 + m * 16 + fr) * 2048 + col0 + bj * HALF + 4 * n));
#pragma unroll
            for (int m = 0; m < 4; ++m) { const int rl = ai * HALF + wr * 64 + m * 16 + fr; float s = 0.f;
#pragma unroll
                for (int bj = 0; bj < 2; ++bj)
#pragma unroll
                    for (int n = 0; n < 2; ++n) { const f32x4 v = xv[m][bj][n] + gv[bj][n] * acc[ai][bj][m][n];
                        acc[ai][bj][m][n] = v; s += (v[0] * v[0] + v[1] * v[1]) + (v[2] * v[2] + v[3] * v[3]); }
                s += __shfl_xor(s, 16); s += __shfl_xor(s, 32);
                if (fq == 0) P[rl * 4 + wc] = s; } }
        asm volatile("s_waitcnt lgkmcnt(0)" ::: "memory"); __builtin_amdgcn_s_barrier(); asm volatile("" ::: "memory");
        const int rrow = wid * 32 + (lane & 31);
        if (lane < 32) { const float t = (P[rrow * 4 + 0] + P[rrow * 4 + 1]) + (P[rrow * 4 + 2] + P[rrow * 4 + 3]);
            __hip_atomic_store(xbuf + (size_t)(u.pm * BM + rrow) * 8 + u.pn, __float_as_uint(t), __ATOMIC_RELAXED, __HIP_MEMORY_SCOPE_AGENT); }
        asm volatile("s_waitcnt vmcnt(0)" ::: "memory");
        if (lane == 0) __hip_atomic_fetch_add(cnt + 64 * u.pm, 1u, __ATOMIC_RELAXED, __HIP_MEMORY_SCOPE_AGENT);
        if (wid == 0) { unsigned sp = 0;
            for (;;) { if ((unsigned)__builtin_amdgcn_readfirstlane(__hip_atomic_load(cnt + 64 * u.pm, __ATOMIC_RELAXED, __HIP_MEMORY_SCOPE_AGENT)) >= 64u) break;
                if (++sp > (1u << 22)) break; __builtin_amdgcn_s_sleep(2); }
            __builtin_amdgcn_fence(__ATOMIC_ACQUIRE, "agent"); }
        asm volatile("s_waitcnt vmcnt(0) lgkmcnt(0)" ::: "memory"); __builtin_amdgcn_s_barrier(); asm volatile("" ::: "memory");
        if (lane < 32) { const unsigned* slot = xbuf + (size_t)(u.pm * BM + rrow) * 8; float t = 0.f;
#pragma unroll
            for (int p = 0; p < 8; ++p) t += __uint_as_float(__hip_atomic_load(slot + p, __ATOMIC_RELAXED, __HIP_MEMORY_SCOPE_AGENT));
            S[rrow] = 1.0f / sqrtf(t * (1.0f / 2048.0f) + eps); }
        asm volatile("s_waitcnt lgkmcnt(0)" ::: "memory"); __builtin_amdgcn_s_barrier(); asm volatile("" ::: "memory");
        f32x4 fv[2][2];
#pragma unroll
        for (int bj = 0; bj < 2; ++bj)
#pragma unroll
            for (int n = 0; n < 2; ++n) fv[bj][n] = *(const f32x4*)(fg + col0 + bj * HALF + 4 * n);
#pragma unroll
        for (int ai = 0; ai < 2; ++ai)
#pragma unroll
            for (int m = 0; m < 4; ++m) { const int rl = ai * HALF + wr * 64 + m * 16 + fr; const float rs = S[rl];
#pragma unroll
                for (int bj = 0; bj < 2; ++bj)
#pragma unroll
                    for (int n = 0; n < 2; ++n) { const size_t off = (size_t)(u.pm * BM + rl) * 2048 + col0 + bj * HALF + 4 * n;
                        *(f32x4*)(out + off) = acc[ai][bj][m][n] * rs * fv[bj][n]; } }
    }
};


struct EpiGateAttn {
    static constexpr bool PERM = true, AFTER_DRAIN = true;
    const bf16_t* O1; const bf16_t* O2; const float* subln_g; bf16_t* MIX; float lam, eps;
    __device__ __forceinline__ void fused(f32x4 (&acc)[2][2][4][2], const Unit& u, int wr, int wc, int fr, int fq, PG8_LAS unsigned char* lds, int wid, int lane) const {
        PG8_LAS float* P = (PG8_LAS float*)lds;
        const int cw = wc * 32 + 8 * fq, dim0 = (u.pn - 12) * 256 + cw;
#pragma unroll
        for (int ai = 0; ai < 2; ++ai)
#pragma unroll
            for (int m = 0; m < 4; ++m) { const int rl = ai * HALF + wr * 64 + m * 16 + fr; const size_t ro = (size_t)(u.pm * BM + rl) * 1024 + dim0;
#pragma unroll
                for (int bj = 0; bj < 2; ++bj) { const u32x4 a = *(const u32x4*)(O1 + ro + bj * HALF), b = *(const u32x4*)(O2 + ro + bj * HALF);
                    const f32x4 o0 = bf_lo4(a.x, a.y) - lam * bf_lo4(b.x, b.y), o1 = bf_lo4(a.z, a.w) - lam * bf_lo4(b.z, b.w);
                    float s = (o0[0] * o0[0] + o0[1] * o0[1]) + (o0[2] * o0[2] + o0[3] * o0[3]) + (o1[0] * o1[0] + o1[1] * o1[1]) + (o1[2] * o1[2] + o1[3] * o1[3]);
                    s += __shfl_xor(s, 16); s += __shfl_xor(s, 32);
                    if (fq == 0) P[(rl * 2 + bj) * 4 + wc] = s; } }
        asm volatile("s_waitcnt lgkmcnt(0)" ::: "memory"); __builtin_amdgcn_s_barrier(); asm volatile("" ::: "memory");
        f32x4 gs[2];
#pragma unroll
        for (int n = 0; n < 2; ++n) gs[n] = *(const f32x4*)(subln_g + cw + 4 * n) * 0.8f;
#pragma unroll
        for (int ai = 0; ai < 2; ++ai)
#pragma unroll
            for (int m = 0; m < 4; ++m) { const int rl = ai * HALF + wr * 64 + m * 16 + fr; const size_t ro = (size_t)(u.pm * BM + rl) * 1024 + dim0;
#pragma unroll
                for (int bj = 0; bj < 2; ++bj) { const f32x4 p = *(const PG8_LAS f32x4*)(P + (rl * 2 + bj) * 4);
                    const float rs = 1.0f / sqrtf(((p[0] + p[1]) + (p[2] + p[3])) * (1.0f / 128.0f) + eps);
                    const u32x4 a = *(const u32x4*)(O1 + ro + bj * HALF), b = *(const u32x4*)(O2 + ro + bj * HALF);
                    const f32x4 o0 = bf_lo4(a.x, a.y) - lam * bf_lo4(b.x, b.y), o1 = bf_lo4(a.z, a.w) - lam * bf_lo4(b.z, b.w);
                    store8(MIX + (size_t)(u.pm * BM + rl) * 2048 + dim0 + bj * HALF, o0 * rs * gs[0] * silu4(acc[ai][bj][m][0]), o1 * rs * gs[1] * silu4(acc[ai][bj][m][1])); } }
    }
};
struct OrderSkipGA { StaticOrder o;
    __device__ bool next(int i, Unit& u) const { if (!o.next(i, u)) return false; if (u.pn >= 12) u.pn += 4; return true; }
    __device__ __forceinline__ void a_ready(const Unit&) const {}
    __device__ __forceinline__ void done(const Unit&) const {} };
struct OrderOne { int pm, pn;
    __device__ bool next(int i, Unit& u) const { if (i > 0 || pm < 0) return false; u.pm = pm; u.pn = pn; return true; }
    __device__ __forceinline__ void a_ready(const Unit&) const {}
    __device__ __forceinline__ void done(const Unit&) const {} };
struct OrderGA { int j;
    __device__ bool next(int i, Unit& u) const { if (i > 0 || j < 0 || j >= 128) return false; u.pm = j >> 2; u.pn = 12 + (j & 3); return true; }
    __device__ __forceinline__ void a_ready(const Unit&) const {}
    __device__ __forceinline__ void done(const Unit&) const {} };

template <class Epi, class Sched, bool ALIGN_EPI = false, bool SP2 = false>
__device__ __forceinline__ void gemm_phase(PG8_LAS unsigned char* lds, const Gemm g, const Sched& S, const Epi& E) {
    const int tid = threadIdx.x, wid = __builtin_amdgcn_readfirstlane(tid >> 6), lane = tid & 63, wr = wid >> 2, wc = wid & 3, fr = lane & 15, fq = lane >> 4;
    const int K = g.K, nt = K / BK;
    unsigned voffA[2], voffB[2];
#pragma unroll
    for (int i = 0; i < 2; ++i) { int R, C; stage_rc(tid * 16 + i * 8192, R, C); const int Rb = Epi::PERM ? ((R & ~31) + perm32(R & 31)) : R;
        voffA[i] = (unsigned)(R * K + C) * 2u; voffB[i] = (unsigned)(Rb * K + C) * 2u; }
    const size_t kstep = (size_t)(BK * 2);
    const size_t hstep = (size_t)HALF * K * 2;
    const size_t tstep = 2 * hstep;
    const unsigned ldsw = (unsigned)wid * 1024u;
    const int aoff = lds_byte(wr * 64 + fr, fq * 8), boff = lds_byte(wc * 32 + fr, fq * 8);
#define PG8_SA(b, h) (((b) * 2 + (h)) * HTB)
#define PG8_SB(b, h) ((4 + (b) * 2 + (h)) * HTB)
#define PG8_STAGE(bufoff, gbase, voff) do { _Pragma("unroll") for (int _i = 0; _i < 2; ++_i) \
        __builtin_amdgcn_global_load_lds((const unsigned*)((const char*)(gbase) + (voff)[_i]), (PG8_LAS unsigned*)(lds + (bufoff) + ldsw + _i * 8192), 16, 0, 0); } while (0)
#define PG8_LDA(dst, b, h) do { _Pragma("unroll") for (int m = 0; m < 4; ++m) _Pragma("unroll") for (int k = 0; k < 2; ++k) dst[m][k] = *(const PG8_LAS bf16x8*)(lds + PG8_SA(b, h) + aoff + m * 2048 + k * 1024); } while (0)
#define PG8_LDB(dst, b, h) do { _Pragma("unroll") for (int n = 0; n < 2; ++n) _Pragma("unroll") for (int k = 0; k < 2; ++k) dst[n][k] = *(const PG8_LAS bf16x8*)(lds + PG8_SB(b, h) + boff + n * 2048 + k * 1024); } while (0)
#define PG8_MMA(ai, bj, At, Bt) do { __builtin_amdgcn_s_setprio(1); _Pragma("unroll") for (int m = 0; m < 4; ++m) _Pragma("unroll") for (int n = 0; n < 2; ++n) _Pragma("unroll") for (int k = 0; k < 2; ++k) \
        acc[ai][bj][m][n] = __builtin_amdgcn_mfma_f32_16x16x32_bf16(Bt[n][k], At[m][k], acc[ai][bj][m][n], 0, 0, 0); __builtin_amdgcn_s_setprio(0); } while (0)
#define PG8_WAIT_V(n) asm volatile("s_waitcnt vmcnt(" #n ")" ::: "memory")
#define PG8_WAIT_L(n) asm volatile("s_waitcnt lgkmcnt(" #n ")" ::: "memory")
#define PG8_BAR __builtin_amdgcn_s_barrier()
#define PG8_SCHED __builtin_amdgcn_sched_barrier(0)
    Unit cur, nxt; int ui = 0;
    if (!S.next(0, cur)) return;
    f32x4 acc[2][2][4][2];
#pragma unroll
    for (int a = 0; a < 2; ++a)
#pragma unroll
        for (int b = 0; b < 2; ++b)
#pragma unroll
            for (int m = 0; m < 4; ++m)
#pragma unroll
                for (int n = 0; n < 2; ++n) acc[a][b][m][n] = (f32x4){0.f, 0.f, 0.f, 0.f};
    bf16x8 At[4][2], B0[2][2], B1[2][2];
    const char* cA = (const char*)g.A + (size_t)cur.pm * tstep; const char* cB = (const char*)g.Bt + (size_t)cur.pn * tstep;
    S.a_ready(cur);
    if constexpr (SP2) {
        PG8_STAGE(PG8_SB(0, 0), cB, voffB); PG8_STAGE(PG8_SB(0, 1), cB + hstep, voffB); PG8_STAGE(PG8_SA(0, 0), cA, voffA); PG8_STAGE(PG8_SA(0, 1), cA + hstep, voffA);
        if (wr == 1) PG8_BAR;
        PG8_WAIT_V(2); PG8_BAR;
        PG8_STAGE(PG8_SB(1, 0), cB + kstep, voffB); PG8_STAGE(PG8_SA(1, 0), cA + kstep, voffA); PG8_STAGE(PG8_SB(1, 1), cB + hstep + kstep, voffB);
        PG8_WAIT_V(6); PG8_BAR;
    } else {
        PG8_STAGE(PG8_SB(0, 0), cB, voffB); PG8_STAGE(PG8_SA(0, 0), cA, voffA); PG8_STAGE(PG8_SB(0, 1), cB + hstep, voffB); PG8_STAGE(PG8_SA(0, 1), cA + hstep, voffA);
        if (wr == 1) PG8_BAR;
        PG8_WAIT_V(4); PG8_BAR;
        PG8_STAGE(PG8_SB(1, 0), cB + kstep, voffB); PG8_STAGE(PG8_SA(1, 0), cA + kstep, voffA); PG8_STAGE(PG8_SB(1, 1), cB + hstep + kstep, voffB);
        PG8_WAIT_V(6); PG8_BAR;
    }
    for (;;) {
        const bool has_next = S.next(ui + 1, nxt);
        const char* nA = has_next ? (const char*)g.A + (size_t)nxt.pm * tstep : cA; const char* nB = has_next ? (const char*)g.Bt + (size_t)nxt.pn * tstep : cB;
        for (int t = 0; t < nt; t += 2) {
            const bool last = (t == nt - 2);
            const char* a1 = cA + (size_t)(t + 1) * kstep;
            const char* a2 = last ? nA : cA + (size_t)(t + 2) * kstep; const char* b2 = last ? nB : cB + (size_t)(t + 2) * kstep;
            const char* a3 = a2 + kstep; const char* b3 = b2 + kstep;
            if (last && has_next) S.a_ready(nxt);
            if constexpr (SP2) {
            PG8_LDB(B0, 0, 0); PG8_LDB(B1, 0, 1); PG8_SCHED; PG8_LDA(At, 0, 0); PG8_STAGE(PG8_SA(1, 1), a1 + hstep, voffA);
            PG8_WAIT_V(8); PG8_WAIT_L(0); PG8_BAR; PG8_MMA(0, 0, At, B0); PG8_MMA(0, 1, At, B1); PG8_BAR; PG8_SCHED;
            PG8_LDA(At, 0, 1); PG8_STAGE(PG8_SB(0, 0), b2, voffB); PG8_STAGE(PG8_SB(0, 1), b2 + hstep, voffB); PG8_STAGE(PG8_SA(0, 0), a2, voffA);
            PG8_WAIT_V(8); PG8_WAIT_L(0); PG8_BAR; PG8_MMA(1, 0, At, B0); PG8_MMA(1, 1, At, B1); PG8_BAR; PG8_SCHED;
            PG8_LDB(B0, 1, 0); PG8_LDB(B1, 1, 1); PG8_SCHED; PG8_LDA(At, 1, 0); PG8_STAGE(PG8_SA(0, 1), a2 + hstep, voffA);
            PG8_WAIT_V(8); PG8_WAIT_L(0); PG8_BAR; PG8_MMA(0, 0, At, B0); PG8_MMA(0, 1, At, B1); PG8_BAR; PG8_SCHED;
            PG8_LDA(At, 1, 1); PG8_STAGE(PG8_SB(1, 0), b3, voffB); PG8_STAGE(PG8_SB(1, 1), b3 + hstep, voffB); PG8_STAGE(PG8_SA(1, 0), a3, voffA);
            PG8_WAIT_V(8); PG8_WAIT_L(0); PG8_BAR; PG8_MMA(1, 0, At, B0); PG8_MMA(1, 1, At, B1); PG8_BAR; PG8_SCHED;
            } else {
            PG8_LDB(B0, 0, 0); PG8_SCHED; PG8_LDA(At, 0, 0); PG8_STAGE(PG8_SA(1, 1), a1 + hstep, voffA);
            PG8_WAIT_L(8); PG8_BAR; PG8_WAIT_L(0); PG8_MMA(0, 0, At, B0); PG8_BAR; PG8_SCHED;
            PG8_LDB(B1, 0, 1); PG8_STAGE(PG8_SB(0, 0), b2, voffB);
            PG8_BAR; PG8_WAIT_L(0); PG8_MMA(0, 1, At, B1); PG8_BAR;
            PG8_LDA(At, 0, 1); PG8_STAGE(PG8_SA(0, 0), a2, voffA);
            PG8_BAR; PG8_WAIT_L(0); PG8_MMA(1, 0, At, B0); PG8_BAR; PG8_SCHED;
            PG8_STAGE(PG8_SB(0, 1), b2 + hstep, voffB);
            PG8_WAIT_V(6); PG8_BAR; PG8_MMA(1, 1, At, B1); PG8_BAR;
            PG8_LDB(B0, 1, 0); PG8_SCHED; PG8_LDA(At, 1, 0); PG8_STAGE(PG8_SA(0, 1), a2 + hstep, voffA);
            PG8_WAIT_L(8); PG8_BAR; PG8_WAIT_L(0); PG8_MMA(0, 0, At, B0); PG8_BAR; PG8_SCHED;
            PG8_LDB(B1, 1, 1); PG8_STAGE(PG8_SB(1, 0), b3, voffB);
            PG8_BAR; PG8_WAIT_L(0); PG8_MMA(0, 1, At, B1); PG8_BAR;
            PG8_LDA(At, 1, 1); PG8_STAGE(PG8_SA(1, 0), a3, voffA);
            PG8_BAR; PG8_WAIT_L(0); PG8_MMA(1, 0, At, B0); PG8_BAR; PG8_SCHED;
            PG8_STAGE(PG8_SB(1, 1), b3 + hstep, voffB);
            PG8_WAIT_V(6); PG8_BAR; PG8_MMA(1, 1, At, B1); PG8_BAR;
            }
        }
        if constexpr (ALIGN_EPI) { if (wr == 0) PG8_BAR; }
        if constexpr (!Epi::AFTER_DRAIN) { E(acc, cur, wr, wc, fr, fq); S.done(cur); }
        if (!has_next) break;
#pragma unroll
        for (int a = 0; a < 2; ++a)
#pragma unroll
            for (int b = 0; b < 2; ++b)
#pragma unroll
                for (int m = 0; m < 4; ++m)
#pragma unroll
                    for (int n = 0; n < 2; ++n) acc[a][b][m][n] = (f32x4){0.f, 0.f, 0.f, 0.f};
        cur = nxt; cA = nA; cB = nB; ++ui;
        if constexpr (ALIGN_EPI) { if (wr == 1) PG8_BAR; }
    }
    PG8_WAIT_V(0);
    if constexpr (!ALIGN_EPI) { if (wr == 0) PG8_BAR; }
    PG8_BAR;
    if constexpr (Epi::AFTER_DRAIN) { E.fused(acc, cur, wr, wc, fr, fq, lds, wid, lane); S.done(cur); }
#undef PG8_SA
#undef PG8_SB
#undef PG8_STAGE
#undef PG8_LDA
#undef PG8_LDB
#undef PG8_MMA
#undef PG8_WAIT_V
#undef PG8_WAIT_L
#undef PG8_BAR
#undef PG8_SCHED
}
}

#ifndef PG8_SP2
#define PG8_SP2 true
#endif
#ifndef PG8_ALIGN
#define PG8_ALIGN true
#endif
#include <hip/hip_bf16.h>
#include <cmath>
namespace attn_body {
using bf16=__hip_bfloat16;
using bf16x8=__attribute__((ext_vector_type(8)))short;
using s16x4=__attribute__((ext_vector_type(4)))short;
using f32x16=__attribute__((ext_vector_type(16)))float;
using u32x4=__attribute__((ext_vector_type(4)))unsigned;
constexpr int BATCH=2,NHEAD=16,SEQ=4096,D=64,DM=NHEAD*D;
constexpr int NW=8,QBLK=32,QB=QBLK*NW,KVBLK=64,NQB=SEQ/QB;
constexpr int ATTN_PITCH=DM, ATTN_UNIT_ROWS=QB;
__device__ __forceinline__ int crow(int r,int hi){return (r&3)+8*(r>>2)+4*hi;}
#define SBAR() __builtin_amdgcn_sched_barrier(0)
__device__ __forceinline__ void cmask(f32x16&p0,f32x16&p1,int jb,int qrel,int hi){
  const float NEG=-INFINITY; int kb=64*jb+4*hi;
  #pragma unroll
  for(int r=0;r<16;++r){int kv=kb+(r&3)+8*(r>>2); if(kv>qrel)p0[r]=NEG; if(kv+32>qrel)p1[r]=NEG;}
}

constexpr int NSLOT=3, SLOTB=8192, VSLOTB=2*SLOTB;
constexpr int LDS_K=0, LDS_V=NSLOT*SLOTB, LDS_WS=LDS_V+NSLOT*VSLOTB, LDS_OST=LDS_WS+NW*64*4, LDS_BYTES=LDS_OST+NW*4096;
constexpr float C2=0.125f*1.4426950408889634f;
__device__ __forceinline__ void glds16(const void*gsrc,unsigned lds_dst){unsigned keep;
  asm volatile("s_mov_b32 %0, m0\n\ts_mov_b32 m0, %2\n\ts_nop 0\n\tglobal_load_lds_dwordx4 %1, off\n\ts_mov_b32 m0, %0":"=&s"(keep):"v"(gsrc),"s"(lds_dst):"memory");}
__device__ __forceinline__ float max3f(float a,float b,float c){float r;asm("v_max3_f32 %0, %1, %2, %3":"=v"(r):"v"(a),"v"(b),"v"(c));return r;}
__device__ __forceinline__ float max2f(float a,float b){float r;asm("v_max_f32_e32 %0, %1, %2":"=v"(r):"v"(a),"v"(b));return r;}
__device__ __forceinline__ float fadd_s(float a,float b){float r;asm("v_add_f32_e32 %0, %1, %2":"=v"(r):"v"(a),"v"(b));return r;}
__device__ __forceinline__ float fsub_s(float a,float b){float r;asm("v_sub_f32_e32 %0, %1, %2":"=v"(r):"v"(a),"v"(b));return r;}
typedef float f32x2_t __attribute__((ext_vector_type(2))); typedef __bf16 bf16x2_t __attribute__((ext_vector_type(2)));
__device__ __forceinline__ unsigned cvtpk_s(float lo,float hi){f32x2_t v={lo,hi};bf16x2_t b=__builtin_convertvector(v,bf16x2_t);return __builtin_bit_cast(unsigned,b);}
#define WAIT_BAR(N) asm volatile("s_waitcnt vmcnt(" #N ") lgkmcnt(0)\n\ts_barrier":::"memory")

__device__ __forceinline__ void qkt(f32x16&p0,f32x16&p1,const char*Kslot,const bf16x8*qr,const f32x16&negm,int r32,int hi){
  const char*kb=Kslot+hi*1024+r32*16;
  #pragma unroll
  for(int d0=0;d0<4;++d0){
    const bf16x8 b0=*reinterpret_cast<const bf16x8*>(kb+d0*2048);
    const bf16x8 b1=*reinterpret_cast<const bf16x8*>(kb+d0*2048+512);
    if(d0==0){p0=__builtin_amdgcn_mfma_f32_32x32x16_bf16(b0,qr[0],negm,0,0,0);p1=__builtin_amdgcn_mfma_f32_32x32x16_bf16(b1,qr[0],negm,0,0,0);}
    else{p0=__builtin_amdgcn_mfma_f32_32x32x16_bf16(b0,qr[d0],p0,0,0,0);p1=__builtin_amdgcn_mfma_f32_32x32x16_bf16(b1,qr[d0],p1,0,0,0);}}
}
typedef __attribute__((address_space(3))) const char* lds_cptr;
typedef short v4i16_t __attribute__((ext_vector_type(4)));
__device__ __forceinline__ void kload8(bf16x8*kf,lds_cptr kp){
  kf[0]=*(const __attribute__((address_space(3))) bf16x8*)(kp);      kf[1]=*(const __attribute__((address_space(3))) bf16x8*)(kp+512);
  kf[2]=*(const __attribute__((address_space(3))) bf16x8*)(kp+2048); kf[3]=*(const __attribute__((address_space(3))) bf16x8*)(kp+2560);
  kf[4]=*(const __attribute__((address_space(3))) bf16x8*)(kp+4096); kf[5]=*(const __attribute__((address_space(3))) bf16x8*)(kp+4608);
  kf[6]=*(const __attribute__((address_space(3))) bf16x8*)(kp+6144); kf[7]=*(const __attribute__((address_space(3))) bf16x8*)(kp+6656);
}
__device__ __forceinline__ void kload2(bf16x8*kf,lds_cptr kp,int j){ kf[2*j]=*(const __attribute__((address_space(3))) bf16x8*)(kp+j*2048); kf[2*j+1]=*(const __attribute__((address_space(3))) bf16x8*)(kp+j*2048+512); }
__device__ __forceinline__ s16x4 vtr(lds_cptr p){ return __builtin_bit_cast(s16x4,__builtin_amdgcn_ds_read_tr16_b64_v4i16((__attribute__((address_space(3))) v4i16_t*)p)); }
__device__ __forceinline__ float rowmax(const f32x16&p0,const f32x16&p1){
  float a=max3f(p0[0],p0[1],p1[0]),b=max3f(p0[2],p0[3],p1[1]);a=max3f(a,p1[2],p1[3]);
  #pragma unroll
  for(int r=4;r<16;r+=4){a=max3f(a,p0[r],p0[r+1]);b=max3f(b,p0[r+2],p0[r+3]);a=max3f(a,p1[r],p1[r+1]);b=max3f(b,p1[r+2],p1[r+3]);}
  const float m=max2f(a,b);
  auto rr=__builtin_amdgcn_permlane32_swap(__float_as_uint(m),__float_as_uint(m),false,false);
  return max2f(__uint_as_float(rr[0]),__uint_as_float(rr[1]));
}
__device__ __forceinline__ void pv(f32x16*o,int vb,bf16x8 pa0,bf16x8 pa1,bf16x8 pa2,bf16x8 pa3){
  #pragma unroll
  for(int d0=0;d0<4;++d0){s16x4 lo[4],hi[4];
    #pragma unroll
    for(int ks=0;ks<4;++ks){
      asm volatile("ds_read_b64_tr_b16 %0,%1 offset:%c2":"=&v"(lo[ks]):"v"(vb),"i"(d0*4096+ks*1024):"memory");
      asm volatile("ds_read_b64_tr_b16 %0,%1 offset:%c2":"=&v"(hi[ks]):"v"(vb),"i"(d0*4096+ks*1024+512):"memory");}
    asm volatile("s_waitcnt lgkmcnt(0)":::"memory");SBAR();
    #define PK(k) (bf16x8){lo[k][0],lo[k][1],lo[k][2],lo[k][3],hi[k][0],hi[k][1],hi[k][2],hi[k][3]}
    o[d0]=__builtin_amdgcn_mfma_f32_32x32x16_bf16(pa0,PK(0),o[d0],0,0,0);
    o[d0]=__builtin_amdgcn_mfma_f32_32x32x16_bf16(pa1,PK(1),o[d0],0,0,0);
    o[d0]=__builtin_amdgcn_mfma_f32_32x32x16_bf16(pa2,PK(2),o[d0],0,0,0);
    o[d0]=__builtin_amdgcn_mfma_f32_32x32x16_bf16(pa3,PK(3),o[d0],0,0,0);
    #undef PK
  }
}

#ifndef ATTN_STORE16
#define ATTN_STORE16(p,v) (*(u32x4*)(p)=(v))
#endif
template<int THRL> __device__ __forceinline__ void attn_unit(int b,int hq,int hv,int qb,const bf16*Q,const bf16*__restrict__ K,const bf16*__restrict__ V,bf16*O,char*shm){
  int tid_=threadIdx.x; asm volatile("":"+v"(tid_));
  const int tid=tid_,lane=tid&63,r32=lane&31,hi=lane>>5; const int wid=__builtin_amdgcn_readfirstlane(tid>>6);
  const long rowbase=(long)b*SEQ; const int q0=qb*QB;
  const bf16*Qw=Q+(rowbase+q0+wid*QBLK)*DM+hq*D;
  const bf16*Kh=K+rowbase*DM+hq*D,*Vh=V+rowbase*DM+hv*D;
  const unsigned lds0=(unsigned)(uintptr_t)shm;
  float*wsf=(float*)(shm+LDS_WS)+wid*64;
  typedef const __attribute__((address_space(3))) float* lds_cfptr; const lds_cfptr wsfh=(lds_cfptr)((const __attribute__((address_space(3))) char*)shm+LDS_WS)+wid*64+4*hi;
  #define CROW0(r) (((r)&3)+8*((r)>>2))
  const bf16*ksrc=Kh+(long)lane*DM+wid*8;
  const bf16*vsrc=Vh+(long)(16*(wid&3)+(lane>>2))*DM+(wid>>2)*32+(lane&3)*8;
  const unsigned kdst=lds0+LDS_K+wid*1024, vdst=lds0+LDS_V+wid*1024;
  #define DMA_K(t,slot) glds16(ksrc+(long)(t)*KVBLK*DM,(unsigned)__builtin_amdgcn_readfirstlane(kdst+(slot)))
  #define DMA_V(t,slot) do{ glds16(vsrc+(long)(t)*KVBLK*DM,(unsigned)__builtin_amdgcn_readfirstlane(vdst+2*(slot))); glds16(vsrc+(long)(t)*KVBLK*DM+64,(unsigned)__builtin_amdgcn_readfirstlane(vdst+2*(slot)+8192)); }while(0)
  const int vb0=(int)(lds0+LDS_V)+((lane>>4)&1)*32+(lane&3)*8+(4*hi+((lane&15)>>2))*64;
  const char*Kbase=shm+LDS_K; bf16x8 kf[8];
  const lds_cptr shm3=(lds_cptr)shm; const lds_cptr kp0=shm3+LDS_K+hi*1024+r32*16; const lds_cptr vp0=shm3+LDS_V+((lane>>4)&1)*32+(lane&3)*8+(4*hi+((lane&15)>>2))*64;
  const int NT=(q0+QB)/KVBLK;
  DMA_K(0,0);DMA_V(0,0);DMA_K(1,SLOTB);
  bf16x8 qr[4];
  #pragma unroll
  for(int d0=0;d0<4;++d0)qr[d0]=*reinterpret_cast<const bf16x8*>(&Qw[(long)r32*DM+d0*16+hi*8]);
  float mhat=0.f,l_reg=0.f;f32x16 o[4];o[0]=f32x16{};o[1]=f32x16{};o[2]=f32x16{};o[3]=f32x16{};f32x16 negm=f32x16{};asm volatile("":"+v"(negm));
  const int qrel=wid*QBLK+r32;
  #define CMASK(P0,P1,t) do{int jb_=(t)-(NT-4); if(jb_>=0)cmask(P0,P1,jb_,qrel,hi);}while(0)
  bool resc=false;
  #define START(P0,P1) do{ const float rm=rowmax(P0,P1); resc=false; \
    { const float dl=rm; mhat=fadd_s(mhat,dl); \
      _Pragma("unroll") for(int r=0;r<16;++r){P0[r]=fsub_s(P0[r],dl);P1[r]=fsub_s(P1[r],dl);} \
      _Pragma("unroll") for(int r=0;r<16;++r)negm[r]=-mhat; asm volatile("":"+v"(negm)); } \
    _Pragma("unroll") for(int r=0;r<16;++r)P0[r]=__builtin_amdgcn_exp2f(P0[r]); }while(0)
  #define RESC() do{ if(resc){ asm volatile("s_waitcnt lgkmcnt(0)":::"memory"); \
      _Pragma("unroll") for(int d_=0;d_<4;++d_) _Pragma("unroll") for(int r=0;r<16;++r)o[d_][r]*=wsfh[CROW0(r)]; } }while(0)
  f32x16 pA0,pA1,pB0,pB1;
  int sl_prev=0,sl_cur=0,sl_next=SLOTB;
  #define ROT() do{sl_prev=sl_cur;sl_cur=sl_next;sl_next=(sl_next==(NSLOT-1)*SLOTB)?0:sl_next+SLOTB;}while(0)
  DMA_K(2,2*SLOTB);
  WAIT_BAR(4);
  qkt(pA0,pA1,Kbase,qr,negm,r32,hi);asm volatile("s_nop 15\n\ts_nop 7":"+v"(pA0),"+v"(pA1));CMASK(pA0,pA1,0);
  START(pA0,pA1);
  _Pragma("unroll") for(int r=0;r<16;++r)pA1[r]=__builtin_amdgcn_exp2f(pA1[r]);
  WAIT_BAR(0);
  DMA_K(3,0);DMA_V(1,SLOTB);
  ROT();
  kload8(kf,kp0+sl_cur);
  WAIT_BAR(3);
  s16x4 vlo[8],vhi[8]; u32x4 pw0,pw1,pw2,pw3;
  #define PKW(P,B) cvtpk_s(P[B],P[B+1])
  #define PAF(k) __builtin_bit_cast(bf16x8,pw##k)
  #define VFR(i) (bf16x8){vlo[i][0],vlo[i][1],vlo[i][2],vlo[i][3],vhi[i][0],vhi[i][1],vhi[i][2],vhi[i][3]}
  #define PIN(x) asm volatile("":"+v"(x))
  #define MX3(a,b,c) __builtin_fmaxf(__builtin_fmaxf((a),(b)),(c))
  #define GAPA(MF,A0,A1,A2,A3,W0,W1,PW) do{ MF; sacc+=A0; sacc+=A1; sacc+=A2; sacc+=A3; PIN(sacc); W0; W1; PIN(PW); SBAR(); }while(0)
  #define EX(v) __builtin_amdgcn_exp2f(v)
  #define GAPB(MF,X,B) do{ MF; X[B]=EX(X[B]); X[B+1]=EX(X[B+1]); X[B+2]=EX(X[B+2]); X[B+3]=EX(X[B+3]); PIN(X); SBAR(); }while(0)
  #define GAPB2V(MF,F,X,B) do{ MF; VRD2(F); X[B]=EX(X[B]); X[B+1]=EX(X[B+1]); PIN(X); SBAR(); }while(0)
  #define GAPB2(MF,X,B) do{ MF; X[B]=EX(X[B]); X[B+1]=EX(X[B+1]); PIN(X); SBAR(); }while(0)
  #define VRD2(i) do{ vlo[i]=vtr(vp_+(8192+((i)>>2)*4096+((i)&3)*1024)); vhi[i]=vtr(vp_+(8192+((i)>>2)*4096+((i)&3)*1024+512)); }while(0)
  #define VRD(i) do{ vlo[i]=vtr(vp_+(((i)>>2)*4096+((i)&3)*1024)); vhi[i]=vtr(vp_+(((i)>>2)*4096+((i)&3)*1024+512)); }while(0)
  #define KRD(G,j) do{ if(G){ kload2(kf,kp0+sl_next,j); SBAR(); } }while(0)
  #define STEP(C0,C1,P0,P1,t,GK,GV,GL) do{ SBAR(); \
    const lds_cptr vp_=vp0+2*sl_prev; \
    VRD(0); SBAR(); float sacc=(P0[0]+P0[1]); \
    GAPA(C0=__builtin_amdgcn_mfma_f32_32x32x16_bf16(kf[0],qr[0],negm,0,0,0), P0[2],P0[3],P0[4],P0[5],     pw0[0]=PKW(P0,0), pw0[1]=PKW(P0,2), pw0); \
    VRD(4); SBAR(); GAPA(C1=__builtin_amdgcn_mfma_f32_32x32x16_bf16(kf[1],qr[0],negm,0,0,0), P0[6],P0[7],P0[8],P0[9],     pw0[2]=PKW(P0,4), pw0[3]=PKW(P0,6), pw0); \
    VRD(1); SBAR(); GAPA(C0=__builtin_amdgcn_mfma_f32_32x32x16_bf16(kf[2],qr[1],C0,0,0,0),   P0[10],P0[11],P0[12],P0[13], pw1[0]=PKW(P0,8), pw1[1]=PKW(P0,10), pw1); \
    VRD(5); SBAR(); GAPA(C1=__builtin_amdgcn_mfma_f32_32x32x16_bf16(kf[3],qr[1],C1,0,0,0),   P0[14],P0[15],P1[0],P1[1],   pw1[2]=PKW(P0,12),pw1[3]=PKW(P0,14), pw1); \
    VRD(2); SBAR(); GAPA(C0=__builtin_amdgcn_mfma_f32_32x32x16_bf16(kf[4],qr[2],C0,0,0,0),   P1[2],P1[3],P1[4],P1[5],     pw2[0]=PKW(P1,0), pw2[1]=PKW(P1,2), pw2); \
    VRD(6); SBAR(); GAPA(C1=__builtin_amdgcn_mfma_f32_32x32x16_bf16(kf[5],qr[2],C1,0,0,0),   P1[6],P1[7],P1[8],P1[9],     pw2[2]=PKW(P1,4), pw2[3]=PKW(P1,6), pw2); \
    VRD(3); SBAR(); GAPA(C0=__builtin_amdgcn_mfma_f32_32x32x16_bf16(kf[6],qr[3],C0,0,0,0),   P1[10],P1[11],P1[12],P1[13], pw3[0]=PKW(P1,8), pw3[1]=PKW(P1,10), pw3); \
    VRD(7); SBAR(); GAPA(C1=__builtin_amdgcn_mfma_f32_32x32x16_bf16(kf[7],qr[3],C1,0,0,0),   P1[14],P1[15],0.f,0.f,       pw3[2]=PKW(P1,12),pw3[3]=PKW(P1,14), pw3); \
    l_reg+=sacc; \
    if(GK){DMA_K((t)+3,sl_cur);} if(GV){DMA_V((t)+1,sl_next);} \
    CMASK(C0,C1,t); \
    { float a=MX3(C0[0],C0[1],C1[0]),b=MX3(C0[2],C0[3],C1[1]); a=MX3(a,C1[2],C1[3]); \
      _Pragma("unroll") for(int r=4;r<16;r+=4){a=MX3(a,C0[r],C0[r+1]);b=MX3(b,C0[r+2],C0[r+3]);a=MX3(a,C1[r],C1[r+1]);b=MX3(b,C1[r+2],C1[r+3]);} \
      float rm=__builtin_fmaxf(a,b); { auto rr=__builtin_amdgcn_permlane32_swap(__float_as_uint(rm),__float_as_uint(rm),false,false); rm=__builtin_fmaxf(__uint_as_float(rr[0]),__uint_as_float(rr[1])); } \
      resc=false; \
      if(__builtin_expect(__any(rm>(float)THRL),0)){ const float dl=__builtin_fmaxf(rm,0.f); mhat+=dl; \
        _Pragma("unroll") for(int r=0;r<16;++r){C0[r]-=dl;C1[r]-=dl;} \
        _Pragma("unroll") for(int r=0;r<16;++r)negm[r]=-mhat; asm volatile("":"+v"(negm)); \
        const float f=__builtin_amdgcn_exp2f(-dl); l_reg*=f; if(hi==0)wsf[r32]=f; resc=true; } } \
    SBAR(); \
    GAPB2V(o[0]=__builtin_amdgcn_mfma_f32_32x32x16_bf16(PAF(0),VFR(0),o[0],0,0,0), 0, C0,0); \
    GAPB2V(o[1]=__builtin_amdgcn_mfma_f32_32x32x16_bf16(PAF(0),VFR(4),o[1],0,0,0), 4, C0,2); \
    KRD(GL,0); GAPB2V(o[0]=__builtin_amdgcn_mfma_f32_32x32x16_bf16(PAF(1),VFR(1),o[0],0,0,0), 1, C0,4); \
    KRD(GL,1); GAPB2V(o[1]=__builtin_amdgcn_mfma_f32_32x32x16_bf16(PAF(1),VFR(5),o[1],0,0,0), 5, C0,6); \
    KRD(GL,2); GAPB2V(o[0]=__builtin_amdgcn_mfma_f32_32x32x16_bf16(PAF(2),VFR(2),o[0],0,0,0), 2, C0,8); \
    KRD(GL,3); GAPB2V(o[1]=__builtin_amdgcn_mfma_f32_32x32x16_bf16(PAF(2),VFR(6),o[1],0,0,0), 6, C0,10); \
    GAPB2V(o[0]=__builtin_amdgcn_mfma_f32_32x32x16_bf16(PAF(3),VFR(3),o[0],0,0,0), 3, C0,12); \
    GAPB2V(o[1]=__builtin_amdgcn_mfma_f32_32x32x16_bf16(PAF(3),VFR(7),o[1],0,0,0), 7, C0,14); \
    GAPB2(o[2]=__builtin_amdgcn_mfma_f32_32x32x16_bf16(PAF(0),VFR(0),o[2],0,0,0), C1,0); \
    GAPB2(o[3]=__builtin_amdgcn_mfma_f32_32x32x16_bf16(PAF(0),VFR(4),o[3],0,0,0), C1,2); \
    GAPB2(o[2]=__builtin_amdgcn_mfma_f32_32x32x16_bf16(PAF(1),VFR(1),o[2],0,0,0), C1,4); \
    GAPB2(o[3]=__builtin_amdgcn_mfma_f32_32x32x16_bf16(PAF(1),VFR(5),o[3],0,0,0), C1,6); \
    GAPB2(o[2]=__builtin_amdgcn_mfma_f32_32x32x16_bf16(PAF(2),VFR(2),o[2],0,0,0), C1,8); \
    GAPB2(o[3]=__builtin_amdgcn_mfma_f32_32x32x16_bf16(PAF(2),VFR(6),o[3],0,0,0), C1,10); \
    GAPB2(o[2]=__builtin_amdgcn_mfma_f32_32x32x16_bf16(PAF(3),VFR(3),o[2],0,0,0), C1,12); \
    GAPB2(o[3]=__builtin_amdgcn_mfma_f32_32x32x16_bf16(PAF(3),VFR(7),o[3],0,0,0), C1,14); \
    }while(0)
  int t=1;
  #undef CMASK
  #define CMASK(P0,P1,t) do{}while(0)
  for(;t+5<NT;t+=2){
    STEP(pB0,pB1,pA0,pA1,t,true,true,true);     WAIT_BAR(3); RESC(); ROT();
    STEP(pA0,pA1,pB0,pB1,t+1,true,true,true);   WAIT_BAR(3); RESC(); ROT();
  }
  #undef CMASK
  #define CMASK(P0,P1,t) do{int jb_=(t)-(NT-4); if(jb_>=0)cmask(P0,P1,jb_,qrel,hi);}while(0)
  #define ENDW(tt) do{ if((tt)+3<NT){WAIT_BAR(3);} else if((tt)+2<NT){WAIT_BAR(2);} else {WAIT_BAR(0);} }while(0)
  for(;t+1<NT;t+=2){
    STEP(pB0,pB1,pA0,pA1,t,(t+3<NT),(t+1<NT),(t+1<NT));       ENDW(t);   RESC(); ROT();
    STEP(pA0,pA1,pB0,pB1,t+1,(t+4<NT),(t+2<NT),(t+2<NT));     ENDW(t+1); RESC(); ROT();
  }
  STEP(pB0,pB1,pA0,pA1,NT-1,false,false,false); RESC();
  { float sacc=pB0[0]+pB0[1]; _Pragma("unroll") for(int r=2;r<16;++r)sacc+=pB0[r]; _Pragma("unroll") for(int r=0;r<16;++r)sacc+=pB1[r]; l_reg+=sacc;
    pw0=(u32x4){PKW(pB0,0),PKW(pB0,2),PKW(pB0,4),PKW(pB0,6)};pw1=(u32x4){PKW(pB0,8),PKW(pB0,10),PKW(pB0,12),PKW(pB0,14)};pw2=(u32x4){PKW(pB1,0),PKW(pB1,2),PKW(pB1,4),PKW(pB1,6)};pw3=(u32x4){PKW(pB1,8),PKW(pB1,10),PKW(pB1,12),PKW(pB1,14)};
    SBAR(); pv(o,vb0+2*sl_cur,PAF(0),PAF(1),PAF(2),PAF(3)); }
  #undef PKW
  #undef PAF
  #undef VFR
  #undef PIN
  #undef MX3
  #undef GAPA
  #undef GAPB
  #undef EX
  #undef VRD
  #undef VRD2
  #undef GAPB2
  #undef GAPB2V
  #undef KRD
  #undef STEP
  #undef ENDW
  {auto rr=__builtin_amdgcn_permlane32_swap(__float_as_uint(l_reg),__float_as_uint(l_reg),false,false);l_reg=__uint_as_float(rr[0])+__uint_as_float(rr[1]);}
  if(hi==0)wsf[32+r32]=l_reg;asm volatile("s_waitcnt lgkmcnt(0)":::"memory");
  float rli[16];
  #pragma unroll
  for(int r=0;r<16;++r)rli[r]=__builtin_amdgcn_rcpf(wsfh[32+CROW0(r)]);
  bf16*Ow=O+(rowbase+q0+wid*QBLK)*DM+hv*D;
  { bf16*stg=(bf16*)(shm+LDS_OST)+wid*2048;
    #pragma unroll
    for(int hf=0;hf<2;++hf){
    #pragma unroll
    for(int r=0;r<16;++r){const int orow=crow(r,hi);
      #pragma unroll
      for(int d0=0;d0<2;++d0)stg[orow*64+d0*32+r32]=__float2bfloat16(o[2*hf+d0][r]*rli[r]);}
    asm volatile("s_waitcnt lgkmcnt(0)":::"memory");
    #pragma unroll
    for(int i=0;i<4;++i){const int row=i*8+(lane>>3),ch=lane&7; const u32x4 v=*(const u32x4*)(stg+row*64+ch*8); ATTN_STORE16(Ow+(long)row*DM+hf*64+ch*8,v);}
    asm volatile("s_waitcnt lgkmcnt(0)":::"memory"); } }
  asm volatile("s_waitcnt lgkmcnt(0)\n\ts_barrier":::"memory");
  #undef DMA_K
  #undef DMA_V
  #undef CMASK
  #undef START
  #undef RESC
  #undef ROT
  #undef CROW0
}
constexpr int ATTN_LDS_BYTES=LDS_BYTES;
struct AttnTensors { const bf16* Q; const bf16* K; const bf16* V; bf16* O1; bf16* O2; };
struct AttnUnit { int bh; int qb; };
struct StaticOrder {
  int vcu, G;
  __device__ __forceinline__ explicit StaticOrder(int grid,int block):vcu((grid%8==0)?(block%8)*(grid/8)+block/8:block),G(grid){}
  __device__ __forceinline__ bool next(int i,AttnUnit&u)const{
    if(G==256){ if(i>=2)return false; const int s=vcu&7,t=s&3; u.bh=vcu>>3;
      const int hiq=(s<4)?((t<2)?15-t:13-t):((t<2)?13-t:11-t), loq=(s<4)?((t<2)?2+t:4+t):((t<2)?t:2+t);
      u.qb=(i==0)?loq:hiq; return true; }
    const int L=i*G+vcu; if(L>=32*NQB)return false; u.bh=L/NQB; u.qb=NQB-1-(L%NQB); return true; }
  __device__ __forceinline__ void a_ready(const AttnUnit&)const{}
  __device__ __forceinline__ void done(const AttnUnit&)const{}
};
template<class Sched,int THRL=8> __device__ __forceinline__ void attn_phase(char*lds,const AttnTensors&T,const Sched&S){
  AttnUnit u;
  for(int i=0;S.next(i,u);++i){ S.a_ready(u); const int c=u.bh&1,h=(u.bh>>1)&7,b=u.bh>>4;
    attn_unit<THRL>(b,2*h+c,2*h,u.qb,T.Q,T.K,T.V,c?T.O2:T.O1,lds); S.done(u); }
}
#undef SBAR
#undef WAIT_BAR
}
constexpr int NWAVES = 8;
#ifndef MK_N_LAUNCHES
#define MK_N_LAUNCHES 1
#endif
constexpr int N_LAUNCHES = MK_N_LAUNCHES;
#ifndef MK_REP
#define MK_REP {1,1,1,1,1,1}
#endif
constexpr int REP[6] = MK_REP;
constexpr int N_PHASES = 6;

constexpr int SEQ = 4096, DM = 2048, M = 2 * SEQ, DIN = 7168;
constexpr float EPS = 1e-6f;

constexpr size_t MiB = 1u << 20;
constexpr size_t WS_WIN = 2 * MiB, WS_WOUT = 30 * MiB, WS_WPW = 38 * MiB;
constexpr size_t WS_CTL = 0, CTL_ZERO_BYTES = 32768; constexpr int CW_PANEL = 4096, CW_CONV = 6144;
constexpr size_t WS_PTRS = 41 * MiB + 256 * 1024;
constexpr size_t WS_SMALL = 43 * MiB;
constexpr int S_LAM = 0, S_SUBLN = 256, S_DWB = 384, S_LNG = 1408, S_LNB = 2432, S_BPW = 3456, S_FG = 4480, S_NG = 6528, S_BADA = 8576, S_DWW = 14720, S_END = 46464;
constexpr size_t WS_MODP = 40 * MiB, WS_MODF = 41 * MiB, WS_CS = 41 * MiB + 512 * 1024, WS_PART = 42 * MiB;
constexpr size_t WS_HN = 48 * MiB;
constexpr size_t WS_Q = 80 * MiB, WS_K = 96 * MiB, WS_V = 112 * MiB, WS_SGA = 128 * MiB, WS_YG = 144 * MiB, WS_SGC = 160 * MiB;
constexpr size_t WS_O1 = 176 * MiB, WS_O2 = 192 * MiB, WS_CL = 208 * MiB;
constexpr size_t WS_MIX = 224 * MiB, WS_END = 256 * MiB;

constexpr int RING_BYTES = 131072;
constexpr int LDS_BYTES = 147456;
constexpr int MISC_OFF = RING_BYTES + 320;

#define LAS __attribute__((address_space(3)))
typedef unsigned short bf16;
#define GAS __attribute__((address_space(1)))
typedef unsigned v4u __attribute__((ext_vector_type(4)));
typedef unsigned v2u __attribute__((ext_vector_type(2)));
typedef float f32x4 __attribute__((ext_vector_type(4)));
typedef float f32x2 __attribute__((ext_vector_type(2)));

#define XB_TMO      128
#define XB_XCNT(j)  (256  + 64 * (j))
#define XB_XSUB(j)  (1280 + 64 * (j))
#define XB_XGEN(j)  (2304 + 64 * (j))
#define XB_TOP      3328
#define XB_TOPGEN   3392
#define XCD_BAR_WORDS 3456
#define XB_SPIN_CAP (1u << 18)

__device__ __forceinline__ unsigned xb_ld(unsigned* p)              { return __hip_atomic_load(p, __ATOMIC_RELAXED, __HIP_MEMORY_SCOPE_AGENT); }
__device__ __forceinline__ unsigned xb_add(unsigned* p, unsigned v) { return __hip_atomic_fetch_add(p, v, __ATOMIC_RELAXED, __HIP_MEMORY_SCOPE_AGENT); }
__device__ __forceinline__ unsigned xb_xcc_id() { return (unsigned)__builtin_amdgcn_s_getreg((3 << 11) | 20) & 0xFu; }
#define XB_SPIN(cond, bar) do { unsigned _sp = 0; while (cond) { __builtin_amdgcn_s_sleep(1); \
    if ((++_sp & 255u) == 0u) { if (xb_ld(&(bar)[XB_TMO])) break; if (_sp > XB_SPIN_CAP) { atomicAdd(&(bar)[XB_TMO], 1u); break; } } } } while (0)

struct XcdBarrier {
    unsigned* bar; unsigned x;
    volatile LAS unsigned* st;
};

__device__ __forceinline__ XcdBarrier xcd_barrier_post(unsigned* bar, volatile LAS unsigned* st) {
    XcdBarrier b; b.bar = bar; b.x = xb_xcc_id(); b.st = st;
    if (threadIdx.x == 0) (void)xb_add(&bar[XB_XCNT(b.x)], 1u);
    return b;
}
__device__ __forceinline__ void xcd_barrier_complete(unsigned* bar, unsigned x, unsigned& nloc, unsigned& nx) {
    const unsigned G = gridDim.x * gridDim.y * gridDim.z;
    unsigned sum, cnt, mine, sp = 0u;
    for (;;) {
        sum = 0u; cnt = 0u; mine = 0u;
#pragma unroll
        for (unsigned j = 0; j < 16; ++j) { const unsigned c = xb_ld(&bar[XB_XCNT(j)]); sum += c; cnt += (c > 0u) ? 1u : 0u; mine = (j == x) ? c : mine; }
        if (sum == G) break;
        __builtin_amdgcn_s_sleep(1);
        if ((++sp & 255u) == 0u) { if (xb_ld(&bar[XB_TMO])) break; if (sp > XB_SPIN_CAP) { atomicAdd(&bar[XB_TMO], 1u); break; } }
    }
    nloc = mine > 0u ? mine : 1u; nx = cnt > 0u ? cnt : 1u;
}

__device__ __forceinline__ void xcd_barrier(const XcdBarrier& b) {
    asm volatile("s_waitcnt vmcnt(0)" ::: "memory");
    __syncthreads();
    if (threadIdx.x == 0) {
        unsigned* bar = b.bar;
        __builtin_amdgcn_s_waitcnt(0);
        unsigned nloc = b.st[0], nx = b.st[1];
        if (nloc == 0u) { xcd_barrier_complete(bar, b.x, nloc, nx); b.st[0] = nloc; b.st[1] = nx; }
        const unsigned old = xb_add(&bar[XB_XSUB(b.x)], 1u);
        const unsigned gen = old / nloc;
        if (old + 1u == (gen + 1u) * nloc) {
            __builtin_amdgcn_fence(__ATOMIC_RELEASE, "agent");
            asm volatile("s_waitcnt vmcnt(0)" ::: "memory");
            const unsigned og = xb_add(&bar[XB_TOP], 1u);
            const unsigned tg = og / nx;
            if (og + 1u == (tg + 1u) * nx) xb_add(&bar[XB_TOPGEN], 1u);
            else XB_SPIN(xb_ld(&bar[XB_TOPGEN]) == tg, bar);
            __builtin_amdgcn_fence(__ATOMIC_ACQUIRE, "agent");
            xb_add(&bar[XB_XGEN(b.x)], 1u);
            asm volatile("s_waitcnt vmcnt(0)" ::: "memory");
        } else {
            XB_SPIN(xb_ld(&bar[XB_XGEN(b.x)]) == gen, bar);
            __builtin_amdgcn_fence(__ATOMIC_ACQUIRE, "agent");
            asm volatile("s_waitcnt vmcnt(0)" ::: "memory");
        }
    }
    __syncthreads();
}

__device__ __forceinline__ float wave_sum(float v) {
#pragma unroll
    for (int o = 1; o < 64; o <<= 1) v += __shfl_xor(v, o);
    return v;
}
__device__ __forceinline__ unsigned pk2(float lo, float hi) { return pg8::cvt_pk_bf16(lo, hi); }
__device__ __forceinline__ float silu_f(float x) { return x * __builtin_amdgcn_rcpf(1.0f + __expf(-x)); }

__device__ __forceinline__ int win_dest_row(int n0) {
    if (n0 < 4096 || n0 >= 6144) return n0;
    if (n0 < 5120) { const int a = n0 - 4096; return 4096 + (a >> 7) * 256 + (a & 127); }
    const int a = n0 - 5120; return 4096 + (a >> 7) * 256 + 128 + (a & 127);
}
__device__ __forceinline__ void p0_transpose_item(const float* W, int K, int N, bf16* WT, bool remap, LAS float* scr, int item, int lane) {
    const int nblk = N / 32, kb = item / nblk, nb = item % nblk, k0 = 64 * kb, n0 = 32 * nb;
    const int d0 = remap ? win_dest_row(n0) : n0;
    { const int r = lane >> 3, q = lane & 7; f32x4 v[8];
#pragma unroll
      for (int i = 0; i < 8; ++i) v[i] = __builtin_nontemporal_load((const __attribute__((address_space(1))) f32x4*)(W + (size_t)(k0 + 8 * i + r) * N + n0 + 4 * q));
#pragma unroll
      for (int i = 0; i < 8; ++i) { LAS float* d = scr + (8 * i + r) * 33 + 4 * q; d[0] = v[i].x; d[1] = v[i].y; d[2] = v[i].z; d[3] = v[i].w; } }
    asm volatile("s_waitcnt lgkmcnt(0)" ::: "memory");
    const int c = lane & 7;
#pragma unroll
    for (int j = 0; j < 4; ++j) { const int n = (lane >> 3) + 8 * j; const LAS float* s = scr + (8 * c) * 33 + n;
        v4u o; o.x = pk2(s[0 * 33], s[1 * 33]); o.y = pk2(s[2 * 33], s[3 * 33]); o.z = pk2(s[4 * 33], s[5 * 33]); o.w = pk2(s[6 * 33], s[7 * 33]);
        *(v4u*)(WT + (size_t)(d0 + n) * K + k0 + 8 * c) = o; }
    asm volatile("s_waitcnt lgkmcnt(0)" ::: "memory");
}
__device__ __forceinline__ float rope_invf(int i) {
    return i == 0 ? 1.0f : i == 1 ? 0x1.8d275ep-3f : i == 2 ? 0x1.341190p-5f : i == 3 ? 0x1.ddee9cp-8f : i == 4 ? 0x1.72ba44p-10f : i == 5 ? 0x1.1f91f0p-12f : i == 6 ? 0x1.be218ap-15f : 0x1.5a0f50p-17f;
}

template <int R> struct ConvRow {
    static __device__ __forceinline__ void run(f32x2 (&a)[32], const f32x2 (&w)[31], const LAS unsigned* lyu, int tid) {
        const unsigned p = lyu[R * 512 + tid]; const f32x2 y = (f32x2){__uint_as_float(p << 16), __uint_as_float(p & 0xffff0000u)};
#pragma unroll
        for (int t = (R > 30 ? R - 30 : 0); t <= (R < 31 ? R : 31); ++t) a[t] += w[R - t] * y;
        if ((R & 7) == 7) asm volatile("" ::: "memory");
        ConvRow<R + 1>::run(a, w, lyu, tid);
    }
};
template <> struct ConvRow<62> { static __device__ __forceinline__ void run(f32x2 (&)[32], const f32x2 (&)[31], const LAS unsigned*, int) {} };

__device__ __forceinline__ void gemv_item(const float* cvec, const float* w_ada, float* MODP, LAS unsigned char* L, int nchunk, int ks, int tid, int lane, int wave) {
    const int k0 = ks * 256 + wave * 32, n0 = nchunk * 256 + lane * 4;
    float ca0 = 0.f, ca1 = 0.f;
    if (lane < 32) { const float c0 = cvec[k0 + lane], c1 = cvec[2048 + k0 + lane]; ca0 = c0 / (1.0f + expf(-c0)); ca1 = c1 / (1.0f + expf(-c1)); }
    f32x4 a0 = {0.f, 0.f, 0.f, 0.f}, a1 = a0;
#pragma unroll
    for (int r = 0; r < 32; ++r) { const f32x4 w = __builtin_nontemporal_load((const __attribute__((address_space(1))) f32x4*)(w_ada + (size_t)(k0 + r) * 6144 + n0));
        const float s0 = __shfl(ca0, r), s1 = __shfl(ca1, r); a0 += s0 * w; a1 += s1 * w; }
    LAS f32x4* red = (LAS f32x4*)L;
    red[(wave * 2 + 0) * 64 + lane] = a0; red[(wave * 2 + 1) * 64 + lane] = a1;
    __syncthreads();
    { const int b = tid >> 8, col = tid & 255; const LAS float* rf = (const LAS float*)L; float s = 0.f;
#pragma unroll
      for (int w = 0; w < 8; ++w) s += rf[(w * 2 + b) * 256 + col];
      MODP[(size_t)(ks * 2 + b) * 6144 + nchunk * 256 + col] = s; }
    __syncthreads();
}

struct Args { const void* in[20]; float* out; unsigned char* ws; int ph_lo, ph_hi; };

#define WSL(var) unsigned char* var = args.ws; asm volatile("" : "+s"(var))
#define SMALLP(wsl, off) ((const float*)((wsl) + WS_SMALL) + (off))

__global__ void __launch_bounds__(NWAVES * 64, 2) mk_fwd(Args args) {
    extern __shared__ __attribute__((aligned(16))) unsigned char lds[];
    const int tid = threadIdx.x, wave = __builtin_amdgcn_readfirstlane(tid >> 6);
    const int G = gridDim.x, bx = blockIdx.x;
#define PHASE_LANE int lane_ = tid & 63; asm volatile("" : "+v"(lane_)); const int lane = lane_
    LAS unsigned char* L = (LAS unsigned char*)lds;
    const int lo = args.ph_lo, hi = args.ph_hi;
#define IN(k) (lo <= (k) && (k) < hi)
#define SEAM(k) do { if (IN(k) && IN((k) + 1)) xcd_barrier(bar); } while (0)
    for (int u = tid; u < (LDS_BYTES - RING_BYTES) / 4; u += NWAVES * 64) ((LAS unsigned*)(L + RING_BYTES))[u] = 0u;
    __syncthreads();
    XcdBarrier bar; bar.bar = (unsigned*)(args.ws + WS_CTL); bar.x = 0; bar.st = nullptr;
    if (hi - lo > 1) bar = xcd_barrier_post((unsigned*)(args.ws + WS_CTL), (volatile LAS unsigned*)(L + MISC_OFF) + 8);

    if (IN(0)) for (int rep_ = 0; rep_ < REP[0]; ++rep_) {
        WSL(wsl);
        PHASE_LANE;
        const float* cvec = (const float*)args.in[1]; const int* pos = (const int*)args.in[2]; const float* w_ada = (const float*)args.in[4];
        const float* w_in = (const float*)args.in[6]; const float* w_pw = (const float*)args.in[16]; const float* w_out = (const float*)args.in[18];
        bf16* WIN_T = (bf16*)(wsl + WS_WIN); bf16* WOUT_T = (bf16*)(wsl + WS_WOUT); bf16* WPW_T = (bf16*)(wsl + WS_WPW);
        float* MODP = (float*)(wsl + WS_MODP); float* CS = (float*)(wsl + WS_CS); float* SM = (float*)(wsl + WS_SMALL);
        const int vcu = (G % 8 == 0) ? (bx % 8) * (G / 8) + bx / 8 : bx;
        { const int gt = bx * 512 + tid, GT = G * 512;
          { const int e = (G * 512 - 1) - gt;
            if (e < S_END) { const float* src; int o;
              if (e < S_SUBLN) { src = (const float*)args.in[7 + (e >> 6)]; o = e & 63; }
              else if (e < S_DWB) { src = (const float*)args.in[11]; o = e - S_SUBLN; }
              else if (e < S_LNG) { src = (const float*)args.in[13]; o = e - S_DWB; }
              else if (e < S_LNB) { src = (const float*)args.in[14]; o = e - S_LNG; }
              else if (e < S_BPW) { src = (const float*)args.in[15]; o = e - S_LNB; }
              else if (e < S_FG) { src = (const float*)args.in[17]; o = e - S_BPW; }
              else if (e < S_NG) { src = (const float*)args.in[19]; o = e - S_FG; }
              else if (e < S_BADA) { src = (const float*)args.in[3]; o = e - S_NG; }
              else if (e < S_DWW) { src = (const float*)args.in[5]; o = e - S_BADA; }
              else { src = (const float*)args.in[12]; o = e - S_DWW; }
              SM[e] = src[o]; } }
        }
        if (bx == 0 && tid == 0) { const void** pp = (const void**)(wsl + WS_PTRS); pp[0] = args.in[1]; pp[1] = args.in[4]; pp[2] = args.in[18]; }
        for (int item = bx; item < 128; item += G) gemv_item(cvec, w_ada, MODP, L, item % 16, item / 16, tid, lane, wave);
        { LAS float* scr = (LAS float*)(L + wave * 16384);
          const int gw = vcu * NWAVES + wave, NGW = G * NWAVES;
          constexpr int I_IN = 32 * 224, I_PW = 16 * 32;
          const int NPRE = (G == 256) ? 3072 : 0;
          for (int q = 0; q < 3 + (I_IN + I_PW - NPRE + NGW - 1) / NGW; ++q) {
              int it;
              if (q < 3) { if (NPRE == 0 || bx < 128) continue; it = ((bx - 128) * NWAVES + wave) + 1024 * q; }
              else { it = NPRE + gw + (q - 3) * NGW; if (it >= I_IN + I_PW) break; }
              int r = it;
              if (r < I_IN) { p0_transpose_item(w_in, 2048, DIN, WIN_T, true, scr, r, lane); continue; } r -= I_IN;
              p0_transpose_item(w_pw, 1024, 1024, WPW_T, false, scr, r, lane);
          } }
        for (int idx = bx * 512 + tid; idx < M * 8; idx += G * 512) { const int m = idx >> 3, i = idx & 7;
            const float ang = (float)pos[m] * rope_invf(i);
            const double a = (double)ang * 0.15915494309189535; const float f = (float)(a - rint(a));
            CS[(size_t)m * 16 + i] = __builtin_amdgcn_cosf(f); CS[(size_t)m * 16 + 8 + i] = __builtin_amdgcn_sinf(f); }
        __syncthreads();
    }
    SEAM(0);

    if (IN(1)) for (int rep_ = 0; rep_ < REP[1]; ++rep_) {
        WSL(wsl);
        PHASE_LANE;
        const float* x = (const float*)args.in[0]; const float* b_ada = SMALLP(wsl, S_BADA); const float* norm_g = SMALLP(wsl, S_NG);
        const float* MODP = (const float*)(wsl + WS_MODP); float* MODF = (float*)(wsl + WS_MODF); bf16* HN = (bf16*)(wsl + WS_HN);
        LAS float* tabA = (LAS float*)L; LAS float* tabB = tabA + 2048;
        for (int rb = bx; rb < M / 32; rb += G) {
            const int b = (rb * 32) / SEQ;
#pragma unroll
            for (int k = tid; k < 2048; k += 512) { float sh = b_ada[k], sc = b_ada[2048 + k];
#pragma unroll
                for (int ks = 0; ks < 8; ++ks) { sh += MODP[(size_t)(ks * 2 + b) * 6144 + k]; sc += MODP[(size_t)(ks * 2 + b) * 6144 + 2048 + k]; }
                tabA[k] = norm_g[k] * (1.0f + sc); tabB[k] = sh; }
            __syncthreads();
#pragma unroll 1
            for (int rr = 0; rr < 4; rr += 2) { const int m = rb * 32 + wave * 4 + rr;
                const f32x4* xr0 = (const f32x4*)(x + (size_t)m * DM) + lane; const f32x4* xr1 = xr0 + DM / 4; f32x4 v0[8], v1[8]; float s0 = 0.f, s1 = 0.f;
#pragma unroll
                for (int j = 0; j < 8; ++j) { v0[j] = __builtin_nontemporal_load((const __attribute__((address_space(1))) f32x4*)(xr0 + 64 * j)); v1[j] = __builtin_nontemporal_load((const __attribute__((address_space(1))) f32x4*)(xr1 + 64 * j)); }
#pragma unroll
                for (int j = 0; j < 8; ++j) { s0 += (v0[j].x * v0[j].x + v0[j].y * v0[j].y) + (v0[j].z * v0[j].z + v0[j].w * v0[j].w);
                                              s1 += (v1[j].x * v1[j].x + v1[j].y * v1[j].y) + (v1[j].z * v1[j].z + v1[j].w * v1[j].w); }
                const float rstd0 = 1.0f / sqrtf(wave_sum(s0) * (1.0f / DM) + EPS), rstd1 = 1.0f / sqrtf(wave_sum(s1) * (1.0f / DM) + EPS);
                v2u* o8 = (v2u*)(HN + (size_t)m * DM) + lane;
#pragma unroll
                for (int j = 0; j < 8; ++j) { const f32x4 A = *(const LAS f32x4*)(tabA + 4 * lane + 256 * j), B = *(const LAS f32x4*)(tabB + 4 * lane + 256 * j);
                    const f32x4 h0 = v0[j] * rstd0 * A + B, h1 = v1[j] * rstd1 * A + B; v2u w0, w1; w0.x = pk2(h0.x, h0.y); w0.y = pk2(h0.z, h0.w); w1.x = pk2(h1.x, h1.y); w1.y = pk2(h1.z, h1.w);
                    o8[64 * j] = w0; o8[DM / 4 + 64 * j] = w1; } }
            __syncthreads();
        }
    }
    SEAM(1);

    if (IN(2)) for (int rep_ = 0; rep_ < REP[2]; ++rep_) {
        WSL(wsl);
        bf16* HN = (bf16*)(wsl + WS_HN); bf16* WIN_T = (bf16*)(wsl + WS_WIN); bf16* QB = (bf16*)(wsl + WS_Q); bf16* KB = (bf16*)(wsl + WS_K); bf16* VB = (bf16*)(wsl + WS_V);
        bf16* SGA = (bf16*)(wsl + WS_SGA); bf16* YG = (bf16*)(wsl + WS_YG); bf16* SGC = (bf16*)(wsl + WS_SGC); const float* CS = (const float*)(wsl + WS_CS);
        pg8::Gemm g{HN, WIN_T, M, DIN, DM}; pg8::OrderSkipGA S; S.o.init(M, DIN - 1024, G, bx);
        pg8::EpiIn E{QB, KB, VB, SGA, YG, SGC, CS, attn_body::C2};
        pg8::gemm_phase<pg8::EpiIn, pg8::OrderSkipGA, PG8_ALIGN, PG8_SP2>(L, g, S, E);
    }
    SEAM(2);

    if (IN(3)) for (int rep_ = 0; rep_ < REP[3]; ++rep_) {
        WSL(wsl);
        PHASE_LANE;
        const bf16* YG = (const bf16*)(wsl + WS_YG); bf16* CL = (bf16*)(wsl + WS_CL);
        const float* dw_w = SMALLP(wsl, S_DWW); const float* dw_b = SMALLP(wsl, S_DWB); const float* ln_g = SMALLP(wsl, S_LNG); const float* ln_b = SMALLP(wsl, S_LNB);
        for (int tb = bx; tb < M / 32; tb += G) {
            const int m0 = tb * 32, t0 = m0 % SEQ;
            LAS v4u* ly = (LAS v4u*)L;
            { v4u sv[16];
#pragma unroll
              for (int i = 0; i < 16; ++i) { const int ch = tid + 512 * i, r = ch >> 7, cc = ch & 127; sv[i] = (v4u){0u, 0u, 0u, 0u};
                  if (ch < 62 * 128 && t0 - 30 + r >= 0) sv[i] = *(const v4u*)(YG + (size_t)(m0 - 30 + r) * 1024 + cc * 8); }
              f32x2 w[31];
#pragma unroll
              for (int j = 0; j < 31; ++j) w[j] = *(const f32x2*)(dw_w + j * 1024 + 2 * tid);
#pragma unroll
              for (int i = 0; i < 16; ++i) { const int ch = tid + 512 * i; if (ch < 62 * 128) ly[ch] = sv[i]; }
              __syncthreads();
              const f32x2 bias = *(const f32x2*)(dw_b + 2 * tid);
              const LAS unsigned* lyu = (const LAS unsigned*)L;
              f32x2 a[32];
#pragma unroll
              for (int t = 0; t < 32; ++t) a[t] = bias;
              ConvRow<0>::run(a, w, lyu, tid);
              float v[64];
#pragma unroll
              for (int t = 0; t < 32; ++t) { v[t] = a[t].x + a[t].y; v[32 + t] = a[t].x * a[t].x + a[t].y * a[t].y; }
#define BSTEP(h) { const bool up = (lane & (h)) != 0; _Pragma("unroll") for (int i = 0; i < (h); ++i) { const float snd = up ? v[i] : v[i + (h)], keep = up ? v[i + (h)] : v[i]; v[i] = keep + __shfl_xor(snd, (h)); } }
              BSTEP(32) BSTEP(16) BSTEP(8) BSTEP(4) BSTEP(2) BSTEP(1)
#undef BSTEP
              LAS float* red = (LAS float*)(L + 62 * 2048);
              red[wave * 64 + lane] = v[0];
              __syncthreads();
              if (tid < 32) { float sm = 0.f, q = 0.f;
#pragma unroll
                  for (int wv = 0; wv < 8; ++wv) { sm += red[wv * 64 + tid]; q += red[wv * 64 + 32 + tid]; }
                  const float mean = sm * (1.0f / 1024.0f), var = q * (1.0f / 1024.0f) - mean * mean;
                  *(LAS f32x2*)(L + 62 * 2048 + 2048 + 8 * tid) = (f32x2){mean, 1.0f / sqrtf(var + EPS)}; }
              __syncthreads();
              const f32x2 lg = *(const f32x2*)(ln_g + 2 * tid), lb = *(const f32x2*)(ln_b + 2 * tid);
#pragma unroll
              for (int t = 0; t < 32; ++t) { const f32x2 st = *(const LAS f32x2*)(L + 62 * 2048 + 2048 + 8 * t);
                  const f32x2 o = (a[t] - st.x) * st.y * lg + lb;
                  *(unsigned*)(CL + (size_t)(m0 + t) * 1024 + 2 * tid) = pk2(silu_f(o.x), silu_f(o.y)); }
            }
            __syncthreads();
        }
        asm volatile("s_waitcnt vmcnt(0)" ::: "memory"); __syncthreads();
        if (tid == 0) { __builtin_amdgcn_fence(__ATOMIC_RELEASE, "agent"); asm volatile("s_waitcnt vmcnt(0)" ::: "memory");
            __hip_atomic_fetch_add((unsigned*)(wsl + WS_CTL) + CW_CONV, 1u, __ATOMIC_RELAXED, __HIP_MEMORY_SCOPE_AGENT); }
        WSL(wsa);
        const attn_body::AttnTensors AT{(const attn_body::bf16*)(wsa + WS_Q), (const attn_body::bf16*)(wsa + WS_K), (const attn_body::bf16*)(wsa + WS_V), (attn_body::bf16*)(wsa + WS_O1), (attn_body::bf16*)(wsa + WS_O2)};
        const attn_body::StaticOrder S(G, bx);
        attn_body::attn_phase<attn_body::StaticOrder>((char*)lds, AT, S);
        { WSL(wsg);
          const int vcu = (bx % 8) * (G / 8) + bx / 8, idx = (vcu >> 3) * 4 + (vcu & 3);
          if (G == 256 && (vcu & 4) == 0) {
              unsigned* cw = (unsigned*)(wsg + WS_CTL) + CW_CONV;
              if (wave == 0) { unsigned sp = 0;
                  for (;;) { if ((unsigned)__builtin_amdgcn_readfirstlane(__hip_atomic_load(cw, __ATOMIC_RELAXED, __HIP_MEMORY_SCOPE_AGENT)) >= (unsigned)G) break;
                      if (++sp > (1u << 22)) break; __builtin_amdgcn_s_sleep(2); }
                  __builtin_amdgcn_fence(__ATOMIC_ACQUIRE, "agent"); }
              asm volatile("s_waitcnt vmcnt(0) lgkmcnt(0)" ::: "memory"); __syncthreads();
              pg8::Gemm g{(const bf16*)(wsg + WS_CL), (const bf16*)(wsg + WS_WPW), M, 1024, 1024}; pg8::OrderOne S1{idx >> 2, idx & 3};
              pg8::EpiPw E{SMALLP(wsg, S_BPW), (const bf16*)(wsg + WS_SGC), (bf16*)(wsg + WS_MIX)};
              pg8::gemm_phase<pg8::EpiPw, pg8::OrderOne, false, PG8_SP2>(L, g, S1, E);
          } else if (G == 256) {
              pg8::Gemm g{(const bf16*)(wsg + WS_HN), (const bf16*)(wsg + WS_WIN), M, DIN, DM}; pg8::OrderGA S1{idx};
              pg8::EpiIn E{(bf16*)(wsg + WS_Q), (bf16*)(wsg + WS_K), (bf16*)(wsg + WS_V), (bf16*)(wsg + WS_SGA), (bf16*)(wsg + WS_YG), (bf16*)(wsg + WS_SGC), (const float*)(wsg + WS_CS), attn_body::C2};
              pg8::gemm_phase<pg8::EpiIn, pg8::OrderGA, false, PG8_SP2>(L, g, S1, E);
              const int lane = tid & 63;
              const float* cvec = (const float*)((const void* const*)(wsg + WS_PTRS))[0]; const float* w_ada = (const float*)((const void* const*)(wsg + WS_PTRS))[1]; const float* w_out = (const float*)((const void* const*)(wsg + WS_PTRS))[2];
              { LAS float* scr = (LAS float*)(L + wave * 16384);
                for (int it = idx * NWAVES + wave; it < 32 * 64; it += 128 * NWAVES) p0_transpose_item(w_out, 2048, 2048, (bf16*)(wsg + WS_WOUT), false, scr, it, lane); }
              __syncthreads();
              if (idx < 64) gemv_item(cvec, w_ada, (float*)(wsg + WS_MODP), L, 16 + (idx & 7), idx >> 3, tid, lane, wave);
          } }
    }
    SEAM(3);

    if (IN(4)) for (int rep_ = 0; rep_ < REP[4]; ++rep_) {
        WSL(wsl);
        PHASE_LANE;
        bf16* MIX = (bf16*)(wsl + WS_MIX);
        const bf16* O1 = (const bf16*)(wsl + WS_O1); const bf16* O2 = (const bf16*)(wsl + WS_O2); const bf16* SGA = (const bf16*)(wsl + WS_SGA);
        const float* lamv = SMALLP(wsl, S_LAM); const float* subln_g = SMALLP(wsl, S_SUBLN);
        { const float* b_ada = SMALLP(wsl, S_BADA); const float* MODP = (const float*)(wsl + WS_MODP); float* MODF = (float*)(wsl + WS_MODF);
          for (int idx = bx * 512 + tid; idx < 2 * 2048; idx += G * 512) { const int b = idx >> 11, n = 4096 + (idx & 2047); float sgt = b_ada[n];
#pragma unroll
              for (int ks = 0; ks < 8; ++ks) sgt += MODP[(size_t)(ks * 2 + b) * 6144 + n];
              MODF[b * 6144 + n] = sgt; } }
        const float lam = expf(wave_sum(lamv[lane] * lamv[64 + lane])) - expf(wave_sum(lamv[128 + lane] * lamv[192 + lane])) + 0.2f;
        f32x4 sg[4];
#pragma unroll
        for (int i = 0; i < 4; ++i) sg[i] = *(const f32x4*)(subln_g + 16 * (lane & 7) + 4 * i) * 0.8f;
#pragma unroll 4
        for (int m = bx * NWAVES + wave; m < M; m += G * NWAVES) {
            const size_t off = (size_t)m * 1024 + 16 * lane;
#define NTL(p) __builtin_nontemporal_load((const __attribute__((address_space(1))) v4u*)(p))
            const v4u a0 = NTL(O1 + off), a1 = NTL(O1 + off + 8), b0 = NTL(O2 + off), b1 = NTL(O2 + off + 8);
            const v4u g0 = NTL(SGA + off), g1 = NTL(SGA + off + 8);
#undef NTL
            f32x4 o[4];
            o[0] = pg8::bf_lo4(a0.x, a0.y) - lam * pg8::bf_lo4(b0.x, b0.y); o[1] = pg8::bf_lo4(a0.z, a0.w) - lam * pg8::bf_lo4(b0.z, b0.w);
            o[2] = pg8::bf_lo4(a1.x, a1.y) - lam * pg8::bf_lo4(b1.x, b1.y); o[3] = pg8::bf_lo4(a1.z, a1.w) - lam * pg8::bf_lo4(b1.z, b1.w);
            float ss = 0.f;
#pragma unroll
            for (int i = 0; i < 4; ++i) ss += (o[i].x * o[i].x + o[i].y * o[i].y) + (o[i].z * o[i].z + o[i].w * o[i].w);
            ss += __shfl_xor(ss, 1); ss += __shfl_xor(ss, 2); ss += __shfl_xor(ss, 4);
            const float rs = 1.0f / sqrtf(ss * (1.0f / 128.0f) + EPS);
            const f32x4 y0 = o[0] * rs * sg[0] * pg8::bf_lo4(g0.x, g0.y), y1 = o[1] * rs * sg[1] * pg8::bf_lo4(g0.z, g0.w);
            const f32x4 y2 = o[2] * rs * sg[2] * pg8::bf_lo4(g1.x, g1.y), y3 = o[3] * rs * sg[3] * pg8::bf_lo4(g1.z, g1.w);
            bf16* dst = MIX + (size_t)m * 2048 + 16 * lane;
            pg8::store8(dst, y0, y1); pg8::store8(dst + 8, y2, y3);
        }
    }
    SEAM(4);

    if (IN(5)) for (int rep_ = 0; rep_ < REP[5]; ++rep_) {
        WSL(wsl);
        const float* x = (const float*)args.in[0]; float* out = args.out;
        bf16* MIX = (bf16*)(wsl + WS_MIX); bf16* WOUT_T = (bf16*)(wsl + WS_WOUT); const float* MODF = (const float*)(wsl + WS_MODF);
        pg8::Gemm g{MIX, WOUT_T, M, 2048, 2048}; pg8::StaticOrder S; S.init(M, 2048, G, bx); S.wgm = 4;
        pg8::EpiOutNorm E{x, MODF, SMALLP(wsl, S_FG), out, (unsigned*)(wsl + WS_PART), (unsigned*)(wsl + WS_CTL) + CW_PANEL, EPS};
        pg8::gemm_phase<pg8::EpiOutNorm, pg8::StaticOrder, false, PG8_SP2>(L, g, S, E);
    }
#undef IN
#undef SEAM
}

extern "C" void kernel_launch(void* const* d_in, const int* in_sizes, int n_in, void* d_out, int out_size, void* d_ws, size_t ws_size, hipStream_t stream) {
    static int grid = 0;
    if (grid == 0) {
        if (n_in != 20 || out_size != M * DM || ws_size < WS_END) { fprintf(stderr, "kernel_launch: unexpected shapes (n_in %d, out %d, ws %zu); nothing launched\n", n_in, out_size, ws_size); grid = -1; return; }
        int dev = 0, cus = 0, per_cu = 0;
        if (hipGetDevice(&dev) != hipSuccess || hipDeviceGetAttribute(&cus, hipDeviceAttributeMultiprocessorCount, dev) != hipSuccess) { grid = -1; return; }
        if (hipFuncSetAttribute((const void*)mk_fwd, hipFuncAttributeMaxDynamicSharedMemorySize, LDS_BYTES) != hipSuccess) { fprintf(stderr, "kernel_launch: hipFuncSetAttribute failed\n"); grid = -1; return; }
        if (hipOccupancyMaxActiveBlocksPerMultiprocessor(&per_cu, (const void*)mk_fwd, NWAVES * 64, LDS_BYTES) != hipSuccess || per_cu < 1) { fprintf(stderr, "kernel_launch: occupancy query says %d blocks per CU\n", per_cu); (void)hipGetLastError(); per_cu = 1; }
        grid = cus * 1;
        if (grid > 256) grid = 256;
    }
    if (grid < 0) return;
    if (hipMemsetAsync((char*)d_ws + WS_CTL, 0, CTL_ZERO_BYTES, stream) != hipSuccess) { fprintf(stderr, "kernel_launch: hipMemsetAsync failed\n"); return; }
    Args a{};
    for (int i = 0; i < 20; ++i) a.in[i] = d_in[i];
    a.out = (float*)d_out; a.ws = (unsigned char*)d_ws;
    if (N_LAUNCHES == 1) {
        a.ph_lo = 0; a.ph_hi = N_PHASES;
        void* kargs[] = {&a};
        hipError_t e = hipLaunchCooperativeKernel((const void*)mk_fwd, dim3(grid), dim3(NWAVES * 64), kargs, LDS_BYTES, stream);
        if (e != hipSuccess) fprintf(stderr, "kernel_launch: cooperative launch failed: %s (grid %d)\n", hipGetErrorString(e), grid);
    } else {
        for (int p = 0; p < N_PHASES; ++p) { a.ph_lo = p; a.ph_hi = p + 1;
            hipLaunchKernelGGL(mk_fwd, dim3(grid), dim3(NWAVES * 64), LDS_BYTES, stream, a); }
    }
}
```

```cpp
#include <hip/hip_runtime.h>
#include <cstdio>
#include <cstdint>
namespace pg8 {
#define PG8_LAS __attribute__((address_space(3)))
typedef unsigned short bf16_t;
typedef short bf16x8 __attribute__((ext_vector_type(8)));
typedef float f32x4 __attribute__((ext_vector_type(4)));
typedef unsigned u32x4 __attribute__((ext_vector_type(4)));
constexpr int BM = 256, BK = 64, HALF = 128, HTB = HALF * BK * 2  , STAGE_BYTES = 8 * HTB, NXCD = 8, WGM = 8;

__host__ __device__ __forceinline__ int lds_byte(int r, int c) { const int st = (r >> 4) * 2 + (c >> 5), rr = r & 15, cc = c & 31, ob = rr * 64 + cc * 2; return st * 1024 + (ob ^ (((ob >> 9) & 1) << 5)); }
__host__ __device__ __forceinline__ void stage_rc(int b, int& R, int& C) { const int st = b / 1024, sb = b % 1024, swz = sb ^ (((sb >> 9) & 1) << 5); R = (st >> 1) * 16 + swz / 64; C = (st & 1) * 32 + (swz % 64) / 2; }
__host__ __device__ __forceinline__ int perm32(int rho) { const int n = rho >> 4, i = rho & 15; return 8 * (i >> 2) + 4 * n + (i & 3); }

struct Unit { int pm, pn; };
struct Gemm { const bf16_t* A; const bf16_t* Bt; int M, N, K; };

struct StaticOrder {
    int nM, nN, nwg, G, c, wgm;
    __host__ __device__ void init(int M, int N, int G_, int c_) { nM = M / BM; nN = N / BM; nwg = nM * nN; G = G_; c = c_; wgm = WGM; }
    __host__ __device__ bool next(int i, Unit& u) const {
        const long L = (long)i * G + c; if (L >= nwg) return false;
        int wgid = (int)L; { const int q = nwg / NXCD, r = nwg % NXCD, xcd = wgid % NXCD, off = wgid / NXCD; wgid = (xcd < r ? xcd * (q + 1) : r * (q + 1) + (xcd - r) * q) + off; }
        const int nig = wgm * nN, gid = wgid / nig, fm = gid * wgm, gsz = (nM - fm) < wgm ? (nM - fm) : wgm;
        u.pm = fm + ((wgid % nig) % gsz); u.pn = (wgid % nig) / gsz; return true;
    }
    __device__ __forceinline__ void a_ready(const Unit&) const {}
    __device__ __forceinline__ void done(const Unit&) const {}
};

__device__ __forceinline__ unsigned cvt_pk_bf16(float lo, float hi) { unsigned r; asm volatile("v_cvt_pk_bf16_f32 %0, %1, %2" : "=v"(r) : "v"(lo), "v"(hi)); return r; }
__device__ __forceinline__ float fast_sigmoid(float x) { return __builtin_amdgcn_rcpf(1.0f + __expf(-x)); }
__device__ __forceinline__ float fast_silu(float x) { return x * fast_sigmoid(x); }
__device__ __forceinline__ void store8(bf16_t* p, f32x4 v0, f32x4 v1) {
    u32x4 w; w.x = cvt_pk_bf16(v0[0], v0[1]); w.y = cvt_pk_bf16(v0[2], v0[3]); w.z = cvt_pk_bf16(v1[0], v1[1]); w.w = cvt_pk_bf16(v1[2], v1[3]);
    *(__attribute__((address_space(1))) u32x4*)p = w;
}
__device__ __forceinline__ f32x4 silu4(f32x4 v) { return (f32x4){fast_silu(v[0]), fast_silu(v[1]), fast_silu(v[2]), fast_silu(v[3])}; }
__device__ __forceinline__ f32x4 sig4(f32x4 v) { return (f32x4){fast_sigmoid(v[0]), fast_sigmoid(v[1]), fast_sigmoid(v[2]), fast_sigmoid(v[3])}; }
__device__ __forceinline__ f32x4 bf_lo4(unsigned a, unsigned b) { return (f32x4){__uint_as_float(a << 16), __uint_as_float(a & 0xffff0000u), __uint_as_float(b << 16), __uint_as_float(b & 0xffff0000u)}; }

struct EpiIn {
    static constexpr bool PERM = true, AFTER_DRAIN = false;
    bf16_t *Q, *K, *V, *SGA, *YG, *SGC; const float* cs; float qscale;
    __device__ __forceinline__ void operator()(const f32x4 (&acc)[2][2][4][2], const Unit& u, int wr, int wc, int fr, int fq) const {
        const int pn = u.pn; const int row0 = u.pm * BM + wr * 64 + fr; const int cw = wc * 32 + 8 * fq;
        if (pn < 8) {
            bf16_t* base = (pn < 4 ? Q : K) + (pn & 3) * 256 + cw; const float sc = pn < 4 ? qscale : 1.f;
            const bool rot = ((wc & 1) == 0); const float sgn = fq == 0 ? -1.f : 1.f; const bool act = fq < 2;
#pragma unroll
            for (int ai = 0; ai < 2; ++ai) { f32x4 csv[4][4];
                if (rot) {
#pragma unroll
                    for (int m = 0; m < 4; ++m)
#pragma unroll
                        for (int k = 0; k < 4; ++k) csv[m][k] = *((const __attribute__((address_space(1))) f32x4*)(cs + (size_t)(row0 + ai * HALF + m * 16) * 16) + k); }
#pragma unroll
                for (int m = 0; m < 4; ++m) { const int row = row0 + ai * HALF + m * 16;
                    f32x4 c0 = {1.f, 1.f, 1.f, 1.f}, c1 = c0, s0 = {0.f, 0.f, 0.f, 0.f}, s1 = s0;
                    if (rot) { c0 = csv[m][0]; c1 = csv[m][1]; s0 = csv[m][2]; s1 = csv[m][3]; }
#pragma unroll
                    for (int bj = 0; bj < 2; ++bj) { f32x4 v0 = acc[ai][bj][m][0], v1 = acc[ai][bj][m][1];
                        if (rot) { f32x4 p0, p1;
#pragma unroll
                            for (int j = 0; j < 4; ++j) { p0[j] = __shfl_xor(v0[j], 16); p1[j] = __shfl_xor(v1[j], 16); }
                            if (act) { v0 = v0 * c0 + sgn * (p0 * s0); v1 = v1 * c1 + sgn * (p1 * s1); } }
                        v0 = v0 * sc; v1 = v1 * sc; store8(base + (size_t)row * 1024 + bj * HALF, v0, v1); } } }
        } else if (pn < 12) {
            bf16_t* base = V + (pn - 8) * 256 + cw;
#pragma unroll
            for (int ai = 0; ai < 2; ++ai)
#pragma unroll
                for (int m = 0; m < 4; ++m) { const int row = row0 + ai * HALF + m * 16;
#pragma unroll
                    for (int bj = 0; bj < 2; ++bj) store8(base + (size_t)row * 1024 + bj * HALF, acc[ai][bj][m][0], acc[ai][bj][m][1]); }
        } else if (pn < 16 || pn >= 24) {
            bf16_t* base = (pn < 16 ? SGA + (pn - 12) * 256 : SGC + (pn - 24) * 256) + cw;
#pragma unroll
            for (int ai = 0; ai < 2; ++ai)
#pragma unroll
                for (int m = 0; m < 4; ++m) { const int row = row0 + ai * HALF + m * 16;
#pragma unroll
                    for (int bj = 0; bj < 2; ++bj) store8(base + (size_t)row * 1024 + bj * HALF, silu4(acc[ai][bj][m][0]), silu4(acc[ai][bj][m][1])); }
        } else {
            bf16_t* base = YG + (pn - 16) * 128 + cw;
#pragma unroll
            for (int ai = 0; ai < 2; ++ai)
#pragma unroll
                for (int m = 0; m < 4; ++m) { const int row = row0 + ai * HALF + m * 16;
                    store8(base + (size_t)row * 1024, acc[ai][0][m][0] * sig4(acc[ai][1][m][0]), acc[ai][0][m][1] * sig4(acc[ai][1][m][1])); }
        }
    }
};
struct EpiPw {
    static constexpr bool PERM = true, AFTER_DRAIN = false;
    const float* bias; const bf16_t* SGC; bf16_t* MIX;
    __device__ __forceinline__ void operator()(const f32x4 (&acc)[2][2][4][2], const Unit& u, int wr, int wc, int fr, int fq) const {
        const int row0 = u.pm * BM + wr * 64 + fr; const int col0 = u.pn * BM + wc * 32 + 8 * fq;
        f32x4 bv[2][2];
#pragma unroll
        for (int bj = 0; bj < 2; ++bj)
#pragma unroll
            for (int n = 0; n < 2; ++n) bv[bj][n] = *(const f32x4*)(bias + col0 + bj * HALF + 4 * n);
#pragma unroll
        for (int ai = 0; ai < 2; ++ai) { u32x4 gq[4][2];
#pragma unroll
            for (int m = 0; m < 4; ++m)
#pragma unroll
                for (int bj = 0; bj < 2; ++bj) gq[m][bj] = *(const __attribute__((address_space(1))) u32x4*)(SGC + (size_t)(row0 + ai * HALF + m * 16) * 1024 + col0 + bj * HALF);
#pragma unroll
            for (int m = 0; m < 4; ++m) { const int row = row0 + ai * HALF + m * 16;
#pragma unroll
                for (int bj = 0; bj < 2; ++bj) { const u32x4 g = gq[m][bj];
                    const f32x4 v0 = (acc[ai][bj][m][0] + bv[bj][0]) * bf_lo4(g.x, g.y), v1 = (acc[ai][bj][m][1] + bv[bj][1]) * bf_lo4(g.z, g.w);
                    store8(MIX + (size_t)row * 2048 + 1024 + col0 + bj * HALF, v0, v1); } } }
    }
};
struct EpiOut {
    static constexpr bool PERM = true, AFTER_DRAIN = false;
    const float* x; const float* gate; float* out; float* part;
    __device__ __forceinline__ void operator()(const f32x4 (&acc)[2][2][4][2], const Unit& u, int wr, int wc, int fr, int fq) const {
        const int row0 = u.pm * BM + wr * 64 + fr; const int col0 = u.pn * BM + wc * 32 + 8 * fq;
        const float* gp = gate + (size_t)((u.pm * BM) / 4096) * 6144 + 4096 + col0;
        f32x4 gv[2][2];
#pragma unroll
        for (int bj = 0; bj < 2; ++bj)
#pragma unroll
            for (int n = 0; n < 2; ++n) gv[bj][n] = *(const f32x4*)(gp + bj * HALF + 4 * n);
#pragma unroll
        for (int ai = 0; ai < 2; ++ai)
#pragma unroll
            for (int m = 0; m < 4; ++m) { const int row = row0 + ai * HALF + m * 16; float s = 0.f;
#pragma unroll
                for (int bj = 0; bj < 2; ++bj)
#pragma unroll
                    for (int n = 0; n < 2; ++n) { const size_t off = (size_t)row * 2048 + col0 + bj * HALF + 4 * n;
                        const f32x4 v = *(const f32x4*)(x + off) + gv[bj][n] * acc[ai][bj][m][n];
                        *(f32x4*)(out + off) = v; s += (v[0] * v[0] + v[1] * v[1]) + (v[2] * v[2] + v[3] * v[3]); }
                s += __shfl_xor(s, 16); s += __shfl_xor(s, 32);
                if (fq == 0) part[(size_t)row * 32 + u.pn * 4 + wc] = s; }
    }
};


struct EpiOutNorm {
    static constexpr bool PERM = true, AFTER_DRAIN = true;
    const float* x; const float* gate; const float* fg; float* out; unsigned* xbuf; unsigned* cnt; float eps;
    __device__ __forceinline__ void fused(f32x4 (&acc)[2][2][4][2], const Unit& u, int wr, int wc, int fr, int fq, PG8_LAS unsigned char* lds, int wid, int lane) const {
        PG8_LAS float* P = (PG8_LAS float*)lds;
        PG8_LAS float* S = (PG8_LAS float*)(lds + 4096);
        const int col0 = u.pn * BM + wc * 32 + 8 * fq;
        const float* gp = gate + (size_t)((u.pm * BM) / 4096) * 6144 + 4096 + col0;
        f32x4 gv[2][2];
#pragma unroll
        for (int bj = 0; bj < 2; ++bj)
#pragma unroll
            for (int n = 0; n < 2; ++n) gv[bj][n] = *(const f32x4*)(gp + bj * HALF + 4 * n);
#pragma unroll
        for (int ai = 0; ai < 2; ++ai) { f32x4 xv[4][2][2];
#pragma unroll
            for (int m = 0; m < 4; ++m)
#pragma unroll
                for (int bj = 0; bj < 2; ++bj)
#pragma unroll
                    for (int n = 0; n < 2; ++n) xv[m][bj][n] = __builtin_nontemporal_load((const __attribute__((address_space(1))) f32x4*)(x + (size_t)(u.pm * BM + ai * HALF + wr * 64 + m * 16 + fr) * 2048 + col0 + bj * HALF + 4 * n));
#pragma unroll
            for (int m = 0; m < 4; ++m) { const int rl = ai * HALF + wr * 64 + m * 16 + fr; float s = 0.f;
#pragma unroll
                for (int bj = 0; bj < 2; ++bj)
#pragma unroll
                    for (int n = 0; n < 2; ++n) { const f32x4 v = xv[m][bj][n] + gv[bj][n] * acc[ai][bj][m][n];
                        acc[ai][bj][m][n] = v; s += (v[0] * v[0] + v[1] * v[1]) + (v[2] * v[2] + v[3] * v[3]); }
                s += __shfl_xor(s, 16); s += __shfl_xor(s, 32);
                if (fq == 0) P[rl * 4 + wc] = s; } }
        asm volatile("s_waitcnt lgkmcnt(0)" ::: "memory"); __builtin_amdgcn_s_barrier(); asm volatile("" ::: "memory");
        const int rrow = wid * 32 + (lane & 31);
        if (lane < 32) { const float t = (P[rrow * 4 + 0] + P[rrow * 4 + 1]) + (P[rrow * 4 + 2] + P[rrow * 4 + 3]);
            __hip_atomic_store(xbuf + (size_t)(u.pm * BM + rrow) * 8 + u.pn, __float_as_uint(t), __ATOMIC_RELAXED, __HIP_MEMORY_SCOPE_AGENT); }
        asm volatile("s_waitcnt vmcnt(0)" ::: "memory");
        if (lane == 0) __hip_atomic_fetch_add(cnt + 64 * u.pm, 1u, __ATOMIC_RELAXED, __HIP_MEMORY_SCOPE_AGENT);
        if (wid == 0) { unsigned sp = 0;
            for (;;) { if ((unsigned)__builtin_amdgcn_readfirstlane(__hip_atomic_load(cnt + 64 * u.pm, __ATOMIC_RELAXED, __HIP_MEMORY_SCOPE_AGENT)) >= 64u) break;
                if (++sp > (1u << 22)) break; __builtin_amdgcn_s_sleep(2); }
            __builtin_amdgcn_fence(__ATOMIC_ACQUIRE, "agent"); }
        asm volatile("s_waitcnt vmcnt(0) lgkmcnt(0)" ::: "memory"); __builtin_amdgcn_s_barrier(); asm volatile("" ::: "memory");
        if (lane < 32) { const unsigned* slot = xbuf + (size_t)(u.pm * BM + rrow) * 8; float t = 0.f;
#pragma unroll
            for (int p = 0; p < 8; ++p) t += __uint_as_float(__hip_atomic_load(slot + p, __ATOMIC_RELAXED, __HIP_MEMORY_SCOPE_AGENT));
            S[rrow] = 1.0f / sqrtf(t * (1.0f / 2048.0f) + eps); }
        asm volatile("s_waitcnt lgkmcnt(0)" ::: "memory"); __builtin_amdgcn_s_barrier(); asm volatile("" ::: "memory");
        f32x4 fv[2][2];
#pragma unroll
        for (int bj = 0; bj < 2; ++bj)
#pragma unroll
            for (int n = 0; n < 2; ++n) fv[bj][n] = *(const f32x4*)(fg + col0 + bj * HALF + 4 * n);
#pragma unroll
        for (int ai = 0; ai < 2; ++ai)
#pragma unroll
            for (int m = 0; m < 4; ++m) { const int rl = ai * HALF + wr * 64 + m * 16 + fr; const float rs = S[rl];
#pragma unroll
                for (int bj = 0; bj < 2; ++bj)
#pragma unroll
                    for (int n = 0; n < 2; ++n) { const size_t off = (size_t)(u.pm * BM + rl) * 2048 + col0 + bj * HALF + 4 * n;
                        *(f32x4*)(out + off) = acc[ai][bj][m][n] * rs * fv[bj][n]; } }
    }
};


struct EpiGateAttn {
    static constexpr bool PERM = true, AFTER_DRAIN = true;
    const bf16_t* O1; const bf16_t* O2; const float* subln_g; bf16_t* MIX; float lam, eps;
    __device__ __forceinline__ void fused(f32x4 (&acc)[2][2][4][2], const Unit& u, int wr, int wc, int fr, int fq, PG8_LAS unsigned char* lds, int wid, int lane) const {
        PG8_LAS float* P = (PG8_LAS float*)lds;
        const int cw = wc * 32 + 8 * fq, dim0 = (u.pn - 12) * 256 + cw;
#pragma unroll
        for (int ai = 0; ai < 2; ++ai)
#pragma unroll
            for (int m = 0; m < 4; ++m) { const int rl = ai * HALF + wr * 64 + m * 16 + fr; const size_t ro = (size_t)(u.pm * BM + rl) * 1024 + dim0;
#pragma unroll
                for (int bj = 0; bj < 2; ++bj) { const u32x4 a = *(const u32x4*)(O1 + ro + bj * HALF), b = *(const u32x4*)(O2 + ro + bj * HALF);
                    const f32x4 o0 = bf_lo4(a.x, a.y) - lam * bf_lo4(b.x, b.y), o1 = bf_lo4(a.z, a.w) - lam * bf_lo4(b.z, b.w);
                    float s = (o0[0] * o0[0] + o0[1] * o0[1]) + (o0[2] * o0[2] + o0[3] * o0[3]) + (o1[0] * o1[0] + o1[1] * o1[1]) + (o1[2] * o1[2] + o1[3] * o1[3]);
                    s += __shfl_xor(s, 16); s += __shfl_xor(s, 32);
                    if (fq == 0) P[(rl * 2 + bj) * 4 + wc] = s; } }
        asm volatile("s_waitcnt lgkmcnt(0)" ::: "memory"); __builtin_amdgcn_s_barrier(); asm volatile("" ::: "memory");
        f32x4 gs[2];
#pragma unroll
        for (int n = 0; n < 2; ++n) gs[n] = *(const f32x4*)(subln_g + cw + 4 * n) * 0.8f;
#pragma unroll
        for (int ai = 0; ai < 2; ++ai)
#pragma unroll
            for (int m = 0; m < 4; ++m) { const int rl = ai * HALF + wr * 64 + m * 16 + fr; const size_t ro = (size_t)(u.pm * BM + rl) * 1024 + dim0;
#pragma unroll
                for (int bj = 0; bj < 2; ++bj) { const f32x4 p = *(const PG8_LAS f32x4*)(P + (rl * 2 + bj) * 4);
                    const float rs = 1.0f / sqrtf(((p[0] + p[1]) + (p[2] + p[3])) * (1.0f / 128.0f) + eps);
                    const u32x4 a = *(const u32x4*)(O1 + ro + bj * HALF), b = *(const u32x4*)(O2 + ro + bj * HALF);
                    const f32x4 o0 = bf_lo4(a.x, a.y) - lam * bf_lo4(b.x, b.y), o1 = bf_lo4(a.z, a.w) - lam * bf_lo4(b.z, b.w);
                    store8(MIX + (size_t)(u.pm * BM + rl) * 2048 + dim0 + bj * HALF, o0 * rs * gs[0] * silu4(acc[ai][bj][m][0]), o1 * rs * gs[1] * silu4(acc[ai][bj][m][1])); } }
    }
};
struct OrderSkipGA { StaticOrder o;
    __device__ bool next(int i, Unit& u) const { if (!o.next(i, u)) return false; if (u.pn >= 12) u.pn += 4; return true; }
    __device__ __forceinline__ void a_ready(const Unit&) const {}
    __device__ __forceinline__ void done(const Unit&) const {} };
struct OrderOne { int pm, pn;
    __device__ bool next(int i, Unit& u) const { if (i > 0 || pm < 0) return false; u.pm = pm; u.pn = pn; return true; }
    __device__ __forceinline__ void a_ready(const Unit&) const {}
    __device__ __forceinline__ void done(const Unit&) const {} };
struct OrderGA { int j;
    __device__ bool next(int i, Unit& u) const { if (i > 0 || j < 0 || j >= 128) return false; u.pm = j >> 2; u.pn = 12 + (j & 3); return true; }
    __device__ __forceinline__ void a_ready(const Unit&) const {}
    __device__ __forceinline__ void done(const Unit&) const {} };

template <class Epi, class Sched, bool ALIGN_EPI = false, bool SP2 = false>
__device__ __forceinline__ void gemm_phase(PG8_LAS unsigned char* lds, const Gemm g, const Sched& S, const Epi& E) {
    const int tid = threadIdx.x, wid = __builtin_amdgcn_readfirstlane(tid >> 6), lane = tid & 63, wr = wid >> 2, wc = wid & 3, fr = lane & 15, fq = lane >> 4;
    const int K = g.K, nt = K / BK;
    unsigned voffA[2], voffB[2];
#pragma unroll
    for (int i = 0; i < 2; ++i) { int R, C; stage_rc(tid * 16 + i * 8192, R, C); const int Rb = Epi::PERM ? ((R & ~31) + perm32(R & 31)) : R;
        voffA[i] = (unsigned)(R * K + C) * 2u; voffB[i] = (unsigned)(Rb * K + C) * 2u; }
    const size_t kstep = (size_t)(BK * 2);
    const size_t hstep = (size_t)HALF * K * 2;
    const size_t tstep = 2 * hstep;
    const unsigned ldsw = (unsigned)wid * 1024u;
    const int aoff = lds_byte(wr * 64 + fr, fq * 8), boff = lds_byte(wc * 32 + fr, fq * 8);
#define PG8_SA(b, h) (((b) * 2 + (h)) * HTB)
#define PG8_SB(b, h) ((4 + (b) * 2 + (h)) * HTB)
#define PG8_STAGE(bufoff, gbase, voff) do { _Pragma("unroll") for (int _i = 0; _i < 2; ++_i) \
        __builtin_amdgcn_global_load_lds((const unsigned*)((const char*)(gbase) + (voff)[_i]), (PG8_LAS unsigned*)(lds + (bufoff) + ldsw + _i * 8192), 16, 0, 0); } while (0)
#define PG8_LDA(dst, b, h) do { _Pragma("unroll") for (int m = 0; m < 4; ++m) _Pragma("unroll") for (int k = 0; k < 2; ++k) dst[m][k] = *(const PG8_LAS bf16x8*)(lds + PG8_SA(b, h) + aoff + m * 2048 + k * 1024); } while (0)
#define PG8_LDB(dst, b, h) do { _Pragma("unroll") for (int n = 0; n < 2; ++n) _Pragma("unroll") for (int k = 0; k < 2; ++k) dst[n][k] = *(const PG8_LAS bf16x8*)(lds + PG8_SB(b, h) + boff + n * 2048 + k * 1024); } while (0)
#define PG8_MMA(ai, bj, At, Bt) do { __builtin_amdgcn_s_setprio(1); _Pragma("unroll") for (int m = 0; m < 4; ++m) _Pragma("unroll") for (int n = 0; n < 2; ++n) _Pragma("unroll") for (int k = 0; k < 2; ++k) \
        acc[ai][bj][m][n] = __builtin_amdgcn_mfma_f32_16x16x32_bf16(Bt[n][k], At[m][k], acc[ai][bj][m][n], 0, 0, 0); __builtin_amdgcn_s_setprio(0); } while (0)
#define PG8_WAIT_V(n) asm volatile("s_waitcnt vmcnt(" #n ")" ::: "memory")
#define PG8_WAIT_L(n) asm volatile("s_waitcnt lgkmcnt(" #n ")" ::: "memory")
#define PG8_BAR __builtin_amdgcn_s_barrier()
#define PG8_SCHED __builtin_amdgcn_sched_barrier(0)
    Unit cur, nxt; int ui = 0;
    if (!S.next(0, cur)) return;
    f32x4 acc[2][2][4][2];
#pragma unroll
    for (int a = 0; a < 2; ++a)
#pragma unroll
        for (int b = 0; b < 2; ++b)
#pragma unroll
            for (int m = 0; m < 4; ++m)
#pragma unroll
                for (int n = 0; n < 2; ++n) acc[a][b][m][n] = (f32x4){0.f, 0.f, 0.f, 0.f};
    bf16x8 At[4][2], B0[2][2], B1[2][2];
    const char* cA = (const char*)g.A + (size_t)cur.pm * tstep; const char* cB = (const char*)g.Bt + (size_t)cur.pn * tstep;
    S.a_ready(cur);
    if constexpr (SP2) {
        PG8_STAGE(PG8_SB(0, 0), cB, voffB); PG8_STAGE(PG8_SB(0, 1), cB + hstep, voffB); PG8_STAGE(PG8_SA(0, 0), cA, voffA); PG8_STAGE(PG8_SA(0, 1), cA + hstep, voffA);
        if (wr == 1) PG8_BAR;
        PG8_WAIT_V(2); PG8_BAR;
        PG8_STAGE(PG8_SB(1, 0), cB + kstep, voffB); PG8_STAGE(PG8_SA(1, 0), cA + kstep, voffA); PG8_STAGE(PG8_SB(1, 1), cB + hstep + kstep, voffB);
        PG8_WAIT_V(6); PG8_BAR;
    } else {
        PG8_STAGE(PG8_SB(0, 0), cB, voffB); PG8_STAGE(PG8_SA(0, 0), cA, voffA); PG8_STAGE(PG8_SB(0, 1), cB + hstep, voffB); PG8_STAGE(PG8_SA(0, 1), cA + hstep, voffA);
        if (wr == 1) PG8_BAR;
        PG8_WAIT_V(4); PG8_BAR;
        PG8_STAGE(PG8_SB(1, 0), cB + kstep, voffB); PG8_STAGE(PG8_SA(1, 0), cA + kstep, voffA); PG8_STAGE(PG8_SB(1, 1), cB + hstep + kstep, voffB);
        PG8_WAIT_V(6); PG8_BAR;
    }
    for (;;) {
        const bool has_next = S.next(ui + 1, nxt);
        const char* nA = has_next ? (const char*)g.A + (size_t)nxt.pm * tstep : cA; const char* nB = has_next ? (const char*)g.Bt + (size_t)nxt.pn * tstep : cB;
        for (int t = 0; t < nt; t += 2) {
            const bool last = (t == nt - 2);
            const char* a1 = cA + (size_t)(t + 1) * kstep;
            const char* a2 = last ? nA : cA + (size_t)(t + 2) * kstep; const char* b2 = last ? nB : cB + (size_t)(t + 2) * kstep;
            const char* a3 = a2 + kstep; const char* b3 = b2 + kstep;
            if (last && has_next) S.a_ready(nxt);
            if constexpr (SP2) {
            PG8_LDB(B0, 0, 0); PG8_LDB(B1, 0, 1); PG8_SCHED; PG8_LDA(At, 0, 0); PG8_STAGE(PG8_SA(1, 1), a1 + hstep, voffA);
            PG8_WAIT_V(8); PG8_WAIT_L(0); PG8_BAR; PG8_MMA(0, 0, At, B0); PG8_MMA(0, 1, At, B1); PG8_BAR; PG8_SCHED;
            PG8_LDA(At, 0, 1); PG8_STAGE(PG8_SB(0, 0), b2, voffB); PG8_STAGE(PG8_SB(0, 1), b2 + hstep, voffB); PG8_STAGE(PG8_SA(0, 0), a2, voffA);
            PG8_WAIT_V(8); PG8_WAIT_L(0); PG8_BAR; PG8_MMA(1, 0, At, B0); PG8_MMA(1, 1, At, B1); PG8_BAR; PG8_SCHED;
            PG8_LDB(B0, 1, 0); PG8_LDB(B1, 1, 1); PG8_SCHED; PG8_LDA(At, 1, 0); PG8_STAGE(PG8_SA(0, 1), a2 + hstep, voffA);
            PG8_WAIT_V(8); PG8_WAIT_L(0); PG8_BAR; PG8_MMA(0, 0, At, B0); PG8_MMA(0, 1, At, B1); PG8_BAR; PG8_SCHED;
            PG8_LDA(At, 1, 1); PG8_STAGE(PG8_SB(1, 0), b3, voffB); PG8_STAGE(PG8_SB(1, 1), b3 + hstep, voffB); PG8_STAGE(PG8_SA(1, 0), a3, voffA);
            PG8_WAIT_V(8); PG8_WAIT_L(0); PG8_BAR; PG8_MMA(1, 0, At, B0); PG8_MMA(1, 1, At, B1); PG8_BAR; PG8_SCHED;
            } else {
            PG8_LDB(B0, 0, 0); PG8_SCHED; PG8_LDA(At, 0, 0); PG8_STAGE(PG8_SA(1, 1), a1 + hstep, voffA);
            PG8_WAIT_L(8); PG8_BAR; PG8_WAIT_L(0); PG8_MMA(0, 0, At, B0); PG8_BAR; PG8_SCHED;
            PG8_LDB(B1, 0, 1); PG8_STAGE(PG8_SB(0, 0), b2, voffB);
            PG8_BAR; PG8_WAIT_L(0); PG8_MMA(0, 1, At, B1); PG8_BAR;
            PG8_LDA(At, 0, 1); PG8_STAGE(PG8_SA(0, 0), a2, voffA);
            PG8_BAR; PG8_WAIT_L(0); PG8_MMA(1, 0, At, B0); PG8_BAR; PG8_SCHED;
            PG8_STAGE(PG8_SB(0, 1), b2 + hstep, voffB);
            PG8_WAIT_V(6); PG8_BAR; PG8_MMA(1, 1, At, B1); PG8_BAR;
            PG8_LDB(B0, 1, 0); PG8_SCHED; PG8_LDA(At, 1, 0); PG8_STAGE(PG8_SA(0, 1), a2 + hstep, voffA);
            PG8_WAIT_L(8); PG8_BAR; PG8_WAIT_L(0); PG8_MMA(0, 0, At, B0); PG8_BAR; PG8_SCHED;
            PG8_LDB(B1, 1, 1); PG8_STAGE(PG8_SB(1, 0), b3, voffB);
            PG8_BAR; PG8_WAIT_L(0); PG8_MMA(0, 1, At, B1); PG8_BAR;
            PG8_LDA(At, 1, 1); PG8_STAGE(PG8_SA(1, 0), a3, voffA);
            PG8_BAR; PG8_WAIT_L(0); PG8_MMA(1, 0, At, B0); PG8_BAR; PG8_SCHED;
            PG8_STAGE(PG8_SB(1, 1), b3 + hstep, voffB);
            PG8_WAIT_V(6); PG8_BAR; PG8_MMA(1, 1, At, B1); PG8_BAR;
            }
        }
        if constexpr (ALIGN_EPI) { if (wr == 0) PG8_BAR; }
        if constexpr (!Epi::AFTER_DRAIN) { E(acc, cur, wr, wc, fr, fq); S.done(cur); }
        if (!has_next) break;
#pragma unroll
        for (int a = 0; a < 2; ++a)
#pragma unroll
            for (int b = 0; b < 2; ++b)
#pragma unroll
                for (int m = 0; m < 4; ++m)
#pragma unroll
                    for (int n = 0; n < 2; ++n) acc[a][b][m][n] = (f32x4){0.f, 0.f, 0.f, 0.f};
        cur = nxt; cA = nA; cB = nB; ++ui;
        if constexpr (ALIGN_EPI) { if (wr == 1) PG8_BAR; }
    }
    PG8_WAIT_V(0);
    if constexpr (!ALIGN_EPI) { if (wr == 0) PG8_BAR; }
    PG8_BAR;
    if constexpr (Epi::AFTER_DRAIN) { E.fused(acc, cur, wr, wc, fr, fq, lds, wid, lane); S.done(cur); }
#undef PG8_SA
#undef PG8_SB
#undef PG8_STAGE
#undef PG8_LDA
#undef PG8_LDB
#undef PG8_MMA
#undef PG8_WAIT_V
#undef PG8_WAIT_L
#undef PG8_BAR
#undef PG8_SCHED
}
}

#ifndef PG8_SP2
#define PG8_SP2 true
#endif
#ifndef PG8_ALIGN
#define PG8_ALIGN true
#endif
#include <hip/hip_bf16.h>
#include <cmath>
namespace attn_body {
using bf16=__hip_bfloat16;
using bf16x8=__attribute__((ext_vector_type(8)))short;
using s16x4=__attribute__((ext_vector_type(4)))short;
using f32x16=__attribute__((ext_vector_type(16)))float;
using u32x4=__attribute__((ext_vector_type(4)))unsigned;
constexpr int BATCH=2,NHEAD=16,SEQ=4096,D=64,DM=NHEAD*D;
constexpr int NW=8,QBLK=32,QB=QBLK*NW,KVBLK=64,NQB=SEQ/QB;
constexpr int ATTN_PITCH=DM, ATTN_UNIT_ROWS=QB;
__device__ __forceinline__ int crow(int r,int hi){return (r&3)+8*(r>>2)+4*hi;}
#define SBAR() __builtin_amdgcn_sched_barrier(0)
__device__ __forceinline__ void cmask(f32x16&p0,f32x16&p1,int jb,int qrel,int hi){
  const float NEG=-INFINITY; int kb=64*jb+4*hi;
  #pragma unroll
  for(int r=0;r<16;++r){int kv=kb+(r&3)+8*(r>>2); if(kv>qrel)p0[r]=NEG; if(kv+32>qrel)p1[r]=NEG;}
}

constexpr int NSLOT=3, SLOTB=8192, VSLOTB=2*SLOTB;
constexpr int LDS_K=0, LDS_V=NSLOT*SLOTB, LDS_WS=LDS_V+NSLOT*VSLOTB, LDS_OST=LDS_WS+NW*64*4, LDS_BYTES=LDS_OST+NW*4096;
constexpr float C2=0.125f*1.4426950408889634f;
__device__ __forceinline__ void glds16(const void*gsrc,unsigned lds_dst){unsigned keep;
  asm volatile("s_mov_b32 %0, m0\n\ts_mov_b32 m0, %2\n\ts_nop 0\n\tglobal_load_lds_dwordx4 %1, off\n\ts_mov_b32 m0, %0":"=&s"(keep):"v"(gsrc),"s"(lds_dst):"memory");}
__device__ __forceinline__ float max3f(float a,float b,float c){float r;asm("v_max3_f32 %0, %1, %2, %3":"=v"(r):"v"(a),"v"(b),"v"(c));return r;}
__device__ __forceinline__ float max2f(float a,float b){float r;asm("v_max_f32_e32 %0, %1, %2":"=v"(r):"v"(a),"v"(b));return r;}
__device__ __forceinline__ float fadd_s(float a,float b){float r;asm("v_add_f32_e32 %0, %1, %2":"=v"(r):"v"(a),"v"(b));return r;}
__device__ __forceinline__ float fsub_s(float a,float b){float r;asm("v_sub_f32_e32 %0, %1, %2":"=v"(r):"v"(a),"v"(b));return r;}
typedef float f32x2_t __attribute__((ext_vector_type(2))); typedef __bf16 bf16x2_t __attribute__((ext_vector_type(2)));
__device__ __forceinline__ unsigned cvtpk_s(float lo,float hi){f32x2_t v={lo,hi};bf16x2_t b=__builtin_convertvector(v,bf16x2_t);return __builtin_bit_cast(unsigned,b);}
#define WAIT_BAR(N) asm volatile("s_waitcnt vmcnt(" #N ") lgkmcnt(0)\n\ts_barrier":::"memory")

__device__ __forceinline__ void qkt(f32x16&p0,f32x16&p1,const char*Kslot,const bf16x8*qr,const f32x16&negm,int r32,int hi){
  const char*kb=Kslot+hi*1024+r32*16;
  #pragma unroll
  for(int d0=0;d0<4;++d0){
    const bf16x8 b0=*reinterpret_cast<const bf16x8*>(kb+d0*2048);
    const bf16x8 b1=*reinterpret_cast<const bf16x8*>(kb+d0*2048+512);
    if(d0==0){p0=__builtin_amdgcn_mfma_f32_32x32x16_bf16(b0,qr[0],negm,0,0,0);p1=__builtin_amdgcn_mfma_f32_32x32x16_bf16(b1,qr[0],negm,0,0,0);}
    else{p0=__builtin_amdgcn_mfma_f32_32x32x16_bf16(b0,qr[d0],p0,0,0,0);p1=__builtin_amdgcn_mfma_f32_32x32x16_bf16(b1,qr[d0],p1,0,0,0);}}
}
typedef __attribute__((address_space(3))) const char* lds_cptr;
typedef short v4i16_t __attribute__((ext_vector_type(4)));
__device__ __forceinline__ void kload8(bf16x8*kf,lds_cptr kp){
  kf[0]=*(const __attribute__((address_space(3))) bf16x8*)(kp);      kf[1]=*(const __attribute__((address_space(3))) bf16x8*)(kp+512);
  kf[2]=*(const __attribute__((address_space(3))) bf16x8*)(kp+2048); kf[3]=*(const __attribute__((address_space(3))) bf16x8*)(kp+2560);
  kf[4]=*(const __attribute__((address_space(3))) bf16x8*)(kp+4096); kf[5]=*(const __attribute__((address_space(3))) bf16x8*)(kp+4608);
  kf[6]=*(const __attribute__((address_space(3))) bf16x8*)(kp+6144); kf[7]=*(const __attribute__((address_space(3))) bf16x8*)(kp+6656);
}
__device__ __forceinline__ void kload2(bf16x8*kf,lds_cptr kp,int j){ kf[2*j]=*(const __attribute__((address_space(3))) bf16x8*)(kp+j*2048); kf[2*j+1]=*(const __attribute__((address_space(3))) bf16x8*)(kp+j*2048+512); }
__device__ __forceinline__ s16x4 vtr(lds_cptr p){ return __builtin_bit_cast(s16x4,__builtin_amdgcn_ds_read_tr16_b64_v4i16((__attribute__((address_space(3))) v4i16_t*)p)); }
__device__ __forceinline__ float rowmax(const f32x16&p0,const f32x16&p1){
  float a=max3f(p0[0],p0[1],p1[0]),b=max3f(p0[2],p0[3],p1[1]);a=max3f(a,p1[2],p1[3]);
  #pragma unroll
  for(int r=4;r<16;r+=4){a=max3f(a,p0[r],p0[r+1]);b=max3f(b,p0[r+2],p0[r+3]);a=max3f(a,p1[r],p1[r+1]);b=max3f(b,p1[r+2],p1[r+3]);}
  const float m=max2f(a,b);
  auto rr=__builtin_amdgcn_permlane32_swap(__float_as_uint(m),__float_as_uint(m),false,false);
  return max2f(__uint_as_float(rr[0]),__uint_as_float(rr[1]));
}
__device__ __forceinline__ void pv(f32x16*o,int vb,bf16x8 pa0,bf16x8 pa1,bf16x8 pa2,bf16x8 pa3){
  #pragma unroll
  for(int d0=0;d0<4;++d0){s16x4 lo[4],hi[4];
    #pragma unroll
    for(int ks=0;ks<4;++ks){
      asm volatile("ds_read_b64_tr_b16 %0,%1 offset:%c2":"=&v"(lo[ks]):"v"(vb),"i"(d0*4096+ks*1024):"memory");
      asm volatile("ds_read_b64_tr_b16 %0,%1 offset:%c2":"=&v"(hi[ks]):"v"(vb),"i"(d0*4096+ks*1024+512):"memory");}
    asm volatile("s_waitcnt lgkmcnt(0)":::"memory");SBAR();
    #define PK(k) (bf16x8){lo[k][0],lo[k][1],lo[k][2],lo[k][3],hi[k][0],hi[k][1],hi[k][2],hi[k][3]}
    o[d0]=__builtin_amdgcn_mfma_f32_32x32x16_bf16(pa0,PK(0),o[d0],0,0,0);
    o[d0]=__builtin_amdgcn_mfma_f32_32x32x16_bf16(pa1,PK(1),o[d0],0,0,0);
    o[d0]=__builtin_amdgcn_mfma_f32_32x32x16_bf16(pa2,PK(2),o[d0],0,0,0);
    o[d0]=__builtin_amdgcn_mfma_f32_32x32x16_bf16(pa3,PK(3),o[d0],0,0,0);
    #undef PK
  }
}

#ifndef ATTN_STORE16
#define ATTN_STORE16(p,v) (*(u32x4*)(p)=(v))
#endif
template<int THRL> __device__ __forceinline__ void attn_unit(int b,int hq,int hv,int qb,const bf16*Q,const bf16*__restrict__ K,const bf16*__restrict__ V,bf16*O,char*shm){
  int tid_=threadIdx.x; asm volatile("":"+v"(tid_));
  const int tid=tid_,lane=tid&63,r32=lane&31,hi=lane>>5; const int wid=__builtin_amdgcn_readfirstlane(tid>>6);
  const long rowbase=(long)b*SEQ; const int q0=qb*QB;
  const bf16*Qw=Q+(rowbase+q0+wid*QBLK)*DM+hq*D;
  const bf16*Kh=K+rowbase*DM+hq*D,*Vh=V+rowbase*DM+hv*D;
  const unsigned lds0=(unsigned)(uintptr_t)shm;
  float*wsf=(float*)(shm+LDS_WS)+wid*64;
  typedef const __attribute__((address_space(3))) float* lds_cfptr; const lds_cfptr wsfh=(lds_cfptr)((const __attribute__((address_space(3))) char*)shm+LDS_WS)+wid*64+4*hi;
  #define CROW0(r) (((r)&3)+8*((r)>>2))
  const bf16*ksrc=Kh+(long)lane*DM+wid*8;
  const bf16*vsrc=Vh+(long)(16*(wid&3)+(lane>>2))*DM+(wid>>2)*32+(lane&3)*8;
  const unsigned kdst=lds0+LDS_K+wid*1024, vdst=lds0+LDS_V+wid*1024;
  #define DMA_K(t,slot) glds16(ksrc+(long)(t)*KVBLK*DM,(unsigned)__builtin_amdgcn_readfirstlane(kdst+(slot)))
  #define DMA_V(t,slot) do{ glds16(vsrc+(long)(t)*KVBLK*DM,(unsigned)__builtin_amdgcn_readfirstlane(vdst+2*(slot))); glds16(vsrc+(long)(t)*KVBLK*DM+64,(unsigned)__builtin_amdgcn_readfirstlane(vdst+2*(slot)+8192)); }while(0)
  const int vb0=(int)(lds0+LDS_V)+((lane>>4)&1)*32+(lane&3)*8+(4*hi+((lane&15)>>2))*64;
  const char*Kbase=shm+LDS_K; bf16x8 kf[8];
  const lds_cptr shm3=(lds_cptr)shm; const lds_cptr kp0=shm3+LDS_K+hi*1024+r32*16; const lds_cptr vp0=shm3+LDS_V+((lane>>4)&1)*32+(lane&3)*8+(4*hi+((lane&15)>>2))*64;
  const int NT=(q0+QB)/KVBLK;
  DMA_K(0,0);DMA_V(0,0);DMA_K(1,SLOTB);
  bf16x8 qr[4];
  #pragma unroll
  for(int d0=0;d0<4;++d0)qr[d0]=*reinterpret_cast<const bf16x8*>(&Qw[(long)r32*DM+d0*16+hi*8]);
  float mhat=0.f,l_reg=0.f;f32x16 o[4];o[0]=f32x16{};o[1]=f32x16{};o[2]=f32x16{};o[3]=f32x16{};f32x16 negm=f32x16{};asm volatile("":"+v"(negm));
  const int qrel=wid*QBLK+r32;
  #define CMASK(P0,P1,t) do{int jb_=(t)-(NT-4); if(jb_>=0)cmask(P0,P1,jb_,qrel,hi);}while(0)
  bool resc=false;
  #define START(P0,P1) do{ const float rm=rowmax(P0,P1); resc=false; \
    { const float dl=rm; mhat=fadd_s(mhat,dl); \
      _Pragma("unroll") for(int r=0;r<16;++r){P0[r]=fsub_s(P0[r],dl);P1[r]=fsub_s(P1[r],dl);} \
      _Pragma("unroll") for(int r=0;r<16;++r)negm[r]=-mhat; asm volatile("":"+v"(negm)); } \
    _Pragma("unroll") for(int r=0;r<16;++r)P0[r]=__builtin_amdgcn_exp2f(P0[r]); }while(0)
  #define RESC() do{ if(resc){ asm volatile("s_waitcnt lgkmcnt(0)":::"memory"); \
      _Pragma("unroll") for(int d_=0;d_<4;++d_) _Pragma("unroll") for(int r=0;r<16;++r)o[d_][r]*=wsfh[CROW0(r)]; } }while(0)
  f32x16 pA0,pA1,pB0,pB1;
  int sl_prev=0,sl_cur=0,sl_next=SLOTB;
  #define ROT() do{sl_prev=sl_cur;sl_cur=sl_next;sl_next=(sl_next==(NSLOT-1)*SLOTB)?0:sl_next+SLOTB;}while(0)
  DMA_K(2,2*SLOTB);
  WAIT_BAR(4);
  qkt(pA0,pA1,Kbase,qr,negm,r32,hi);asm volatile("s_nop 15\n\ts_nop 7":"+v"(pA0),"+v"(pA1));CMASK(pA0,pA1,0);
  START(pA0,pA1);
  _Pragma("unroll") for(int r=0;r<16;++r)pA1[r]=__builtin_amdgcn_exp2f(pA1[r]);
  WAIT_BAR(0);
  DMA_K(3,0);DMA_V(1,SLOTB);
  ROT();
  kload8(kf,kp0+sl_cur);
  WAIT_BAR(3);
  s16x4 vlo[8],vhi[8]; u32x4 pw0,pw1,pw2,pw3;
  #define PKW(P,B) cvtpk_s(P[B],P[B+1])
  #define PAF(k) __builtin_bit_cast(bf16x8,pw##k)
  #define VFR(i) (bf16x8){vlo[i][0],vlo[i][1],vlo[i][2],vlo[i][3],vhi[i][0],vhi[i][1],vhi[i][2],vhi[i][3]}
  #define PIN(x) asm volatile("":"+v"(x))
  #define MX3(a,b,c) __builtin_fmaxf(__builtin_fmaxf((a),(b)),(c))
  #define GAPA(MF,A0,A1,A2,A3,W0,W1,PW) do{ MF; sacc+=A0; sacc+=A1; sacc+=A2; sacc+=A3; PIN(sacc); W0; W1; PIN(PW); SBAR(); }while(0)
  #define EX(v) __builtin_amdgcn_exp2f(v)
  #define GAPB(MF,X,B) do{ MF; X[B]=EX(X[B]); X[B+1]=EX(X[B+1]); X[B+2]=EX(X[B+2]); X[B+3]=EX(X[B+3]); PIN(X); SBAR(); }while(0)
  #define GAPB2V(MF,F,X,B) do{ MF; VRD2(F); X[B]=EX(X[B]); X[B+1]=EX(X[B+1]); PIN(X); SBAR(); }while(0)
  #define GAPB2(MF,X,B) do{ MF; X[B]=EX(X[B]); X[B+1]=EX(X[B+1]); PIN(X); SBAR(); }while(0)
  #define VRD2(i) do{ vlo[i]=vtr(vp_+(8192+((i)>>2)*4096+((i)&3)*1024)); vhi[i]=vtr(vp_+(8192+((i)>>2)*4096+((i)&3)*1024+512)); }while(0)
  #define VRD(i) do{ vlo[i]=vtr(vp_+(((i)>>2)*4096+((i)&3)*1024)); vhi[i]=vtr(vp_+(((i)>>2)*4096+((i)&3)*1024+512)); }while(0)
  #define KRD(G,j) do{ if(G){ kload2(kf,kp0+sl_next,j); SBAR(); } }while(0)
  #define STEP(C0,C1,P0,P1,t,GK,GV,GL) do{ SBAR(); \
    const lds_cptr vp_=vp0+2*sl_prev; \
    VRD(0); SBAR(); float sacc=(P0[0]+P0[1]); \
    GAPA(C0=__builtin_amdgcn_mfma_f32_32x32x16_bf16(kf[0],qr[0],negm,0,0,0), P0[2],P0[3],P0[4],P0[5],     pw0[0]=PKW(P0,0), pw0[1]=PKW(P0,2), pw0); \
    VRD(4); SBAR(); GAPA(C1=__builtin_amdgcn_mfma_f32_32x32x16_bf16(kf[1],qr[0],negm,0,0,0), P0[6],P0[7],P0[8],P0[9],     pw0[2]=PKW(P0,4), pw0[3]=PKW(P0,6), pw0); \
    VRD(1); SBAR(); GAPA(C0=__builtin_amdgcn_mfma_f32_32x32x16_bf16(kf[2],qr[1],C0,0,0,0),   P0[10],P0[11],P0[12],P0[13], pw1[0]=PKW(P0,8), pw1[1]=PKW(P0,10), pw1); \
    VRD(5); SBAR(); GAPA(C1=__builtin_amdgcn_mfma_f32_32x32x16_bf16(kf[3],qr[1],C1,0,0,0),   P0[14],P0[15],P1[0],P1[1],   pw1[2]=PKW(P0,12),pw1[3]=PKW(P0,14), pw1); \
    VRD(2); SBAR(); GAPA(C0=__builtin_amdgcn_mfma_f32_32x32x16_bf16(kf[4],qr[2],C0,0,0,0),   P1[2],P1[3],P1[4],P1[5],     pw2[0]=PKW(P1,0), pw2[1]=PKW(P1,2), pw2); \
    VRD(6); SBAR(); GAPA(C1=__builtin_amdgcn_mfma_f32_32x32x16_bf16(kf[5],qr[2],C1,0,0,0),   P1[6],P1[7],P1[8],P1[9],     pw2[2]=PKW(P1,4), pw2[3]=PKW(P1,6), pw2); \
    VRD(3); SBAR(); GAPA(C0=__builtin_amdgcn_mfma_f32_32x32x16_bf16(kf[6],qr[3],C0,0,0,0),   P1[10],P1[11],P1[12],P1[13], pw3[0]=PKW(P1,8), pw3[1]=PKW(P1,10), pw3); \
    VRD(7); SBAR(); GAPA(C1=__builtin_amdgcn_mfma_f32_32x32x16_bf16(kf[7],qr[3],C1,0,0,0),   P1[14],P1[15],0.f,0.f,       pw3[2]=PKW(P1,12),pw3[3]=PKW(P1,14), pw3); \
    l_reg+=sacc; \
    if(GK){DMA_K((t)+3,sl_cur);} if(GV){DMA_V((t)+1,sl_next);} \
    CMASK(C0,C1,t); \
    { float a=MX3(C0[0],C0[1],C1[0]),b=MX3(C0[2],C0[3],C1[1]); a=MX3(a,C1[2],C1[3]); \
      _Pragma("unroll") for(int r=4;r<16;r+=4){a=MX3(a,C0[r],C0[r+1]);b=MX3(b,C0[r+2],C0[r+3]);a=MX3(a,C1[r],C1[r+1]);b=MX3(b,C1[r+2],C1[r+3]);} \
      float rm=__builtin_fmaxf(a,b); { auto rr=__builtin_amdgcn_permlane32_swap(__float_as_uint(rm),__float_as_uint(rm),false,false); rm=__builtin_fmaxf(__uint_as_float(rr[0]),__uint_as_float(rr[1])); } \
      resc=false; \
      if(__builtin_expect(__any(rm>(float)THRL),0)){ const float dl=__builtin_fmaxf(rm,0.f); mhat+=dl; \
        _Pragma("unroll") for(int r=0;r<16;++r){C0[r]-=dl;C1[r]-=dl;} \
        _Pragma("unroll") for(int r=0;r<16;++r)negm[r]=-mhat; asm volatile("":"+v"(negm)); \
        const float f=__builtin_amdgcn_exp2f(-dl); l_reg*=f; if(hi==0)wsf[r32]=f; resc=true; } } \
    SBAR(); \
    GAPB2V(o[0]=__builtin_amdgcn_mfma_f32_32x32x16_bf16(PAF(0),VFR(0),o[0],0,0,0), 0, C0,0); \
    GAPB2V(o[1]=__builtin_amdgcn_mfma_f32_32x32x16_bf16(PAF(0),VFR(4),o[1],0,0,0), 4, C0,2); \
    KRD(GL,0); GAPB2V(o[0]=__builtin_amdgcn_mfma_f32_32x32x16_bf16(PAF(1),VFR(1),o[0],0,0,0), 1, C0,4); \
    KRD(GL,1); GAPB2V(o[1]=__builtin_amdgcn_mfma_f32_32x32x16_bf16(PAF(1),VFR(5),o[1],0,0,0), 5, C0,6); \
    KRD(GL,2); GAPB2V(o[0]=__builtin_amdgcn_mfma_f32_32x32x16_bf16(PAF(2),VFR(2),o[0],0,0,0), 2, C0,8); \
    KRD(GL,3); GAPB2V(o[1]=__builtin_amdgcn_mfma_f32_32x32x16_bf16(PAF(2),VFR(6),o[1],0,0,0), 6, C0,10); \
    GAPB2V(o[0]=__builtin_amdgcn_mfma_f32_32x32x16_bf16(PAF(3),VFR(3),o[0],0,0,0), 3, C0,12); \
    GAPB2V(o[1]=__builtin_amdgcn_mfma_f32_32x32x16_bf16(PAF(3),VFR(7),o[1],0,0,0), 7, C0,14); \
    GAPB2(o[2]=__builtin_amdgcn_mfma_f32_32x32x16_bf16(PAF(0),VFR(0),o[2],0,0,0), C1,0); \
    GAPB2(o[3]=__builtin_amdgcn_mfma_f32_32x32x16_bf16(PAF(0),VFR(4),o[3],0,0,0), C1,2); \
    GAPB2(o[2]=__builtin_amdgcn_mfma_f32_32x32x16_bf16(PAF(1),VFR(1),o[2],0,0,0), C1,4); \
    GAPB2(o[3]=__builtin_amdgcn_mfma_f32_32x32x16_bf16(PAF(1),VFR(5),o[3],0,0,0), C1,6); \
    GAPB2(o[2]=__builtin_amdgcn_mfma_f32_32x32x16_bf16(PAF(2),VFR(2),o[2],0,0,0), C1,8); \
    GAPB2(o[3]=__builtin_amdgcn_mfma_f32_32x32x16_bf16(PAF(2),VFR(6),o[3],0,0,0), C1,10); \
    GAPB2(o[2]=__builtin_amdgcn_mfma_f32_32x32x16_bf16(PAF(3),VFR(3),o[2],0,0,0), C1,12); \
    GAPB2(o[3]=__builtin_amdgcn_mfma_f32_32x32x16_bf16(PAF(3),VFR(7),o[3],0,0,0), C1,14); \
    }while(0)
  int t=1;
  #undef CMASK
  #define CMASK(P0,P1,t) do{}while(0)
  for(;t+5<NT;t+=2){
    STEP(pB0,pB1,pA0,pA1,t,true,true,true);     WAIT_BAR(3); RESC(); ROT();
    STEP(pA0,pA1,pB0,pB1,t+1,true,true,true);   WAIT_BAR(3); RESC(); ROT();
  }
  #undef CMASK
  #define CMASK(P0,P1,t) do{int jb_=(t)-(NT-4); if(jb_>=0)cmask(P0,P1,jb_,qrel,hi);}while(0)
  #define ENDW(tt) do{ if((tt)+3<NT){WAIT_BAR(3);} else if((tt)+2<NT){WAIT_BAR(2);} else {WAIT_BAR(0);} }while(0)
  for(;t+1<NT;t+=2){
    STEP(pB0,pB1,pA0,pA1,t,(t+3<NT),(t+1<NT),(t+1<NT));       ENDW(t);   RESC(); ROT();
    STEP(pA0,pA1,pB0,pB1,t+1,(t+4<NT),(t+2<NT),(t+2<NT));     ENDW(t+1); RESC(); ROT();
  }
  STEP(pB0,pB1,pA0,pA1,NT-1,false,false,false); RESC();
  { float sacc=pB0[0]+pB0[1]; _Pragma("unroll") for(int r=2;r<16;++r)sacc+=pB0[r]; _Pragma("unroll") for(int r=0;r<16;++r)sacc+=pB1[r]; l_reg+=sacc;
    pw0=(u32x4){PKW(pB0,0),PKW(pB0,2),PKW(pB0,4),PKW(pB0,6)};pw1=(u32x4){PKW(pB0,8),PKW(pB0,10),PKW(pB0,12),PKW(pB0,14)};pw2=(u32x4){PKW(pB1,0),PKW(pB1,2),PKW(pB1,4),PKW(pB1,6)};pw3=(u32x4){PKW(pB1,8),PKW(pB1,10),PKW(pB1,12),PKW(pB1,14)};
    SBAR(); pv(o,vb0+2*sl_cur,PAF(0),PAF(1),PAF(2),PAF(3)); }
  #undef PKW
  #undef PAF
  #undef VFR
  #undef PIN
  #undef MX3
  #undef GAPA
  #undef GAPB
  #undef EX
  #undef VRD
  #undef VRD2
  #undef GAPB2
  #undef GAPB2V
  #undef KRD
  #undef STEP
  #undef ENDW
  {auto rr=__builtin_amdgcn_permlane32_swap(__float_as_uint(l_reg),__float_as_uint(l_reg),false,false);l_reg=__uint_as_float(rr[0])+__uint_as_float(rr[1]);}
  if(hi==0)wsf[32+r32]=l_reg;asm volatile("s_waitcnt lgkmcnt(0)":::"memory");
  float rli[16];
  #pragma unroll
  for(int r=0;r<16;++r)rli[r]=__builtin_amdgcn_rcpf(wsfh[32+CROW0(r)]);
  bf16*Ow=O+(rowbase+q0+wid*QBLK)*DM+hv*D;
  { bf16*stg=(bf16*)(shm+LDS_OST)+wid*2048;
    #pragma unroll
    for(int hf=0;hf<2;++hf){
    #pragma unroll
    for(int r=0;r<16;++r){const int orow=crow(r,hi);
      #pragma unroll
      for(int d0=0;d0<2;++d0)stg[orow*64+d0*32+r32]=__float2bfloat16(o[2*hf+d0][r]*rli[r]);}
    asm volatile("s_waitcnt lgkmcnt(0)":::"memory");
    #pragma unroll
    for(int i=0;i<4;++i){const int row=i*8+(lane>>3),ch=lane&7; const u32x4 v=*(const u32x4*)(stg+row*64+ch*8); ATTN_STORE16(Ow+(long)row*DM+hf*64+ch*8,v);}
    asm volatile("s_waitcnt lgkmcnt(0)":::"memory"); } }
  asm volatile("s_waitcnt lgkmcnt(0)\n\ts_barrier":::"memory");
  #undef DMA_K
  #undef DMA_V
  #undef CMASK
  #undef START
  #undef RESC
  #undef ROT
  #undef CROW0
}
constexpr int ATTN_LDS_BYTES=LDS_BYTES;
struct AttnTensors { const bf16* Q; const bf16* K; const bf16* V; bf16* O1; bf16* O2; };
struct AttnUnit { int bh; int qb; };
struct StaticOrder {
  int vcu, G;
  __device__ __forceinline__ explicit StaticOrder(int grid,int block):vcu((grid%8==0)?(block%8)*(grid/8)+block/8:block),G(grid){}
  __device__ __forceinline__ bool next(int i,AttnUnit&u)const{
    if(G==256){ if(i>=2)return false; const int s=vcu&7,t=s&3; u.bh=vcu>>3;
      const int hiq=(s<4)?((t<2)?15-t:13-t):((t<2)?13-t:11-t), loq=(s<4)?((t<2)?2+t:4+t):((t<2)?t:2+t);
      u.qb=(i==0)?loq:hiq; return true; }
    const int L=i*G+vcu; if(L>=32*NQB)return false; u.bh=L/NQB; u.qb=NQB-1-(L%NQB); return true; }
  __device__ __forceinline__ void a_ready(const AttnUnit&)const{}
  __device__ __forceinline__ void done(const AttnUnit&)const{}
};
template<class Sched,int THRL=8> __device__ __forceinline__ void attn_phase(char*lds,const AttnTensors&T,const Sched&S){
  AttnUnit u;
  for(int i=0;S.next(i,u);++i){ S.a_ready(u); const int c=u.bh&1,h=(u.bh>>1)&7,b=u.bh>>4;
    attn_unit<THRL>(b,2*h+c,2*h,u.qb,T.Q,T.K,T.V,c?T.O2:T.O1,lds); S.done(u); }
}
#undef SBAR
#undef WAIT_BAR
}
constexpr int NWAVES = 8;
#ifndef MK_N_LAUNCHES
#define MK_N_LAUNCHES 1
#endif
constexpr int N_LAUNCHES = MK_N_LAUNCHES;
#ifndef MK_REP
#define MK_REP {1,1,1,1,1,1}
#endif
constexpr int REP[6] = MK_REP;
constexpr int N_PHASES = 6;

constexpr int SEQ = 4096, DM = 2048, M = 2 * SEQ, DIN = 7168;
constexpr float EPS = 1e-6f;

constexpr size_t MiB = 1u << 20;
constexpr size_t WS_WIN = 2 * MiB, WS_WOUT = 30 * MiB, WS_WPW = 38 * MiB;
constexpr size_t WS_CTL = 0, CTL_ZERO_BYTES = 32768; constexpr int CW_PANEL = 4096, CW_CONV = 6144;
constexpr size_t WS_PTRS = 41 * MiB + 256 * 1024;
constexpr size_t WS_SMALL = 43 * MiB;
constexpr int S_LAM = 0, S_SUBLN = 256, S_DWB = 384, S_LNG = 1408, S_LNB = 2432, S_BPW = 3456, S_FG = 4480, S_NG = 6528, S_BADA = 8576, S_DWW = 14720, S_END = 46464;
constexpr size_t WS_MODP = 40 * MiB, WS_MODF = 41 * MiB, WS_CS = 41 * MiB + 512 * 1024, WS_PART = 42 * MiB;
constexpr size_t WS_HN = 48 * MiB;
constexpr size_t WS_Q = 80 * MiB, WS_K = 96 * MiB, WS_V = 112 * MiB, WS_SGA = 128 * MiB, WS_YG = 144 * MiB, WS_SGC = 160 * MiB;
constexpr size_t WS_O1 = 176 * MiB, WS_O2 = 192 * MiB, WS_CL = 208 * MiB;
constexpr size_t WS_MIX = 224 * MiB, WS_END = 256 * MiB;

constexpr int RING_BYTES = 131072;
constexpr int LDS_BYTES = 147456;
constexpr int MISC_OFF = RING_BYTES + 320;

#define LAS __attribute__((address_space(3)))
typedef unsigned short bf16;
#define GAS __attribute__((address_space(1)))
typedef unsigned v4u __attribute__((ext_vector_type(4)));
typedef unsigned v2u __attribute__((ext_vector_type(2)));
typedef float f32x4 __attribute__((ext_vector_type(4)));
typedef float f32x2 __attribute__((ext_vector_type(2)));

#define XB_TMO      128
#define XB_XCNT(j)  (256  + 64 * (j))
#define XB_XSUB(j)  (1280 + 64 * (j))
#define XB_XGEN(j)  (2304 + 64 * (j))
#define XB_TOP      3328
#define XB_TOPGEN   3392
#define XCD_BAR_WORDS 3456
#define XB_SPIN_CAP (1u << 18)

__device__ __forceinline__ unsigned xb_ld(unsigned* p)              { return __hip_atomic_load(p, __ATOMIC_RELAXED, __HIP_MEMORY_SCOPE_AGENT); }
__device__ __forceinline__ unsigned xb_add(unsigned* p, unsigned v) { return __hip_atomic_fetch_add(p, v, __ATOMIC_RELAXED, __HIP_MEMORY_SCOPE_AGENT); }
__device__ __forceinline__ unsigned xb_xcc_id() { return (unsigned)__builtin_amdgcn_s_getreg((3 << 11) | 20) & 0xFu; }
#define XB_SPIN(cond, bar) do { unsigned _sp = 0; while (cond) { __builtin_amdgcn_s_sleep(1); \
    if ((++_sp & 255u) == 0u) { if (xb_ld(&(bar)[XB_TMO])) break; if (_sp > XB_SPIN_CAP) { atomicAdd(&(bar)[XB_TMO], 1u); break; } } } } while (0)

struct XcdBarrier {
    unsigned* bar; unsigned x;
    volatile LAS unsigned* st;
};

__device__ __forceinline__ XcdBarrier xcd_barrier_post(unsigned* bar, volatile LAS unsigned* st) {
    XcdBarrier b; b.bar = bar; b.x = xb_xcc_id(); b.st = st;
    if (threadIdx.x == 0) (void)xb_add(&bar[XB_XCNT(b.x)], 1u);
    return b;
}
__device__ __forceinline__ void xcd_barrier_complete(unsigned* bar, unsigned x, unsigned& nloc, unsigned& nx) {
    const unsigned G = gridDim.x * gridDim.y * gridDim.z;
    unsigned sum, cnt, mine, sp = 0u;
    for (;;) {
        sum = 0u; cnt = 0u; mine = 0u;
#pragma unroll
        for (unsigned j = 0; j < 16; ++j) { const unsigned c = xb_ld(&bar[XB_XCNT(j)]); sum += c; cnt += (c > 0u) ? 1u : 0u; mine = (j == x) ? c : mine; }
        if (sum == G) break;
        __builtin_amdgcn_s_sleep(1);
        if ((++sp & 255u) == 0u) { if (xb_ld(&bar[XB_TMO])) break; if (sp > XB_SPIN_CAP) { atomicAdd(&bar[XB_TMO], 1u); break; } }
    }
    nloc = mine > 0u ? mine : 1u; nx = cnt > 0u ? cnt : 1u;
}

__device__ __forceinline__ void xcd_barrier(const XcdBarrier& b) {
    asm volatile("s_waitcnt vmcnt(0)" ::: "memory");
    __syncthreads();
    if (threadIdx.x == 0) {
        unsigned* bar = b.bar;
        __builtin_amdgcn_s_waitcnt(0);
        unsigned nloc = b.st[0], nx = b.st[1];
        if (nloc == 0u) { xcd_barrier_complete(bar, b.x, nloc, nx); b.st[0] = nloc; b.st[1] = nx; }
        const unsigned old = xb_add(&bar[XB_XSUB(b.x)], 1u);
        const unsigned gen = old / nloc;
        if (old + 1u == (gen + 1u) * nloc) {
            __builtin_amdgcn_fence(__ATOMIC_RELEASE, "agent");
            asm volatile("s_waitcnt vmcnt(0)" ::: "memory");
            const unsigned og = xb_add(&bar[XB_TOP], 1u);
            const unsigned tg = og / nx;
            if (og + 1u == (tg + 1u) * nx) xb_add(&bar[XB_TOPGEN], 1u);
            else XB_SPIN(xb_ld(&bar[XB_TOPGEN]) == tg, bar);
            __builtin_amdgcn_fence(__ATOMIC_ACQUIRE, "agent");
            xb_add(&bar[XB_XGEN(b.x)], 1u);
            asm volatile("s_waitcnt vmcnt(0)" ::: "memory");
        } else {
            XB_SPIN(xb_ld(&bar[XB_XGEN(b.x)]) == gen, bar);
            __builtin_amdgcn_fence(__ATOMIC_ACQUIRE, "agent");
            asm volatile("s_waitcnt vmcnt(0)" ::: "memory");
        }
    }
    __syncthreads();
}

__device__ __forceinline__ float wave_sum(float v) {
#pragma unroll
    for (int o = 1; o < 64; o <<= 1) v += __shfl_xor(v, o);
    return v;
}
__device__ __forceinline__ unsigned pk2(float lo, float hi) { return pg8::cvt_pk_bf16(lo, hi); }
__device__ __forceinline__ float silu_f(float x) { return x * __builtin_amdgcn_rcpf(1.0f + __expf(-x)); }

__device__ __forceinline__ int win_dest_row(int n0) {
    if (n0 < 4096 || n0 >= 6144) return n0;
    if (n0 < 5120) { const int a = n0 - 4096; return 4096 + (a >> 7) * 256 + (a & 127); }
    const int a = n0 - 5120; return 4096 + (a >> 7) * 256 + 128 + (a & 127);
}
__device__ __forceinline__ void p0_transpose_item(const float* W, int K, int N, bf16* WT, bool remap, LAS float* scr, int item, int lane) {
    const int nblk = N / 32, kb = item / nblk, nb = item % nblk, k0 = 64 * kb, n0 = 32 * nb;
    const int d0 = remap ? win_dest_row(n0) : n0;
    { const int r = lane >> 3, q = lane & 7; f32x4 v[8];
#pragma unroll
      for (int i = 0; i < 8; ++i) v[i] = __builtin_nontemporal_load((const __attribute__((address_space(1))) f32x4*)(W + (size_t)(k0 + 8 * i + r) * N + n0 + 4 * q));
#pragma unroll
      for (int i = 0; i < 8; ++i) { LAS float* d = scr + (8 * i + r) * 33 + 4 * q; d[0] = v[i].x; d[1] = v[i].y; d[2] = v[i].z; d[3] = v[i].w; } }
    asm volatile("s_waitcnt lgkmcnt(0)" ::: "memory");
    const int c = lane & 7;
#pragma unroll
    for (int j = 0; j < 4; ++j) { const int n = (lane >> 3) + 8 * j; const LAS float* s = scr + (8 * c) * 33 + n;
        v4u o; o.x = pk2(s[0 * 33], s[1 * 33]); o.y = pk2(s[2 * 33], s[3 * 33]); o.z = pk2(s[4 * 33], s[5 * 33]); o.w = pk2(s[6 * 33], s[7 * 33]);
        *(v4u*)(WT + (size_t)(d0 + n) * K + k0 + 8 * c) = o; }
    asm volatile("s_waitcnt lgkmcnt(0)" ::: "memory");
}
__device__ __forceinline__ void p0_transpose_two(const float* W, int K, int N, bf16* WT, LAS float* scr, int itemA, int itemB, int lane) {
    const int nblk = N / 32, r = lane >> 3, q = lane & 7, c = lane & 7;
    const int kA = 64 * (itemA / nblk), nA = 32 * (itemA % nblk), kB = 64 * (itemB / nblk), nB = 32 * (itemB % nblk);
    f32x4 va[8], vb[8];
#pragma unroll
    for (int i = 0; i < 8; ++i) va[i] = __builtin_nontemporal_load((const __attribute__((address_space(1))) f32x4*)(W + (size_t)(kA + 8 * i + r) * N + nA + 4 * q));
#pragma unroll
    for (int i = 0; i < 8; ++i) vb[i] = __builtin_nontemporal_load((const __attribute__((address_space(1))) f32x4*)(W + (size_t)(kB + 8 * i + r) * N + nB + 4 * q));
#pragma unroll
    for (int h = 0; h < 2; ++h) { const int k0 = h ? kB : kA, n0 = h ? nB : nA;
#pragma unroll
        for (int i = 0; i < 8; ++i) { const f32x4 v = h ? vb[i] : va[i]; LAS float* d = scr + (8 * i + r) * 33 + 4 * q; d[0] = v.x; d[1] = v.y; d[2] = v.z; d[3] = v.w; }
        asm volatile("s_waitcnt lgkmcnt(0)" ::: "memory");
#pragma unroll
        for (int j = 0; j < 4; ++j) { const int n = (lane >> 3) + 8 * j; const LAS float* sp = scr + (8 * c) * 33 + n;
            v4u o; o.x = pk2(sp[0 * 33], sp[1 * 33]); o.y = pk2(sp[2 * 33], sp[3 * 33]); o.z = pk2(sp[4 * 33], sp[5 * 33]); o.w = pk2(sp[6 * 33], sp[7 * 33]);
            *(v4u*)(WT + (size_t)(n0 + n) * K + k0 + 8 * c) = o; }
        asm volatile("s_waitcnt lgkmcnt(0)" ::: "memory"); }
}
__device__ __forceinline__ float rope_invf(int i) {
    return i == 0 ? 1.0f : i == 1 ? 0x1.8d275ep-3f : i == 2 ? 0x1.341190p-5f : i == 3 ? 0x1.ddee9cp-8f : i == 4 ? 0x1.72ba44p-10f : i == 5 ? 0x1.1f91f0p-12f : i == 6 ? 0x1.be218ap-15f : 0x1.5a0f50p-17f;
}

template <int R> struct ConvRow {
    static __device__ __forceinline__ void run(f32x2 (&a)[32], const f32x2 (&w)[31], const LAS unsigned* lyu, int tid) {
        const unsigned p = lyu[R * 512 + tid]; const f32x2 y = (f32x2){__uint_as_float(p << 16), __uint_as_float(p & 0xffff0000u)};
#pragma unroll
        for (int t = (R > 30 ? R - 30 : 0); t <= (R < 31 ? R : 31); ++t) a[t] += w[R - t] * y;
        if ((R & 7) == 7) asm volatile("" ::: "memory");
        ConvRow<R + 1>::run(a, w, lyu, tid);
    }
};
template <> struct ConvRow<62> { static __device__ __forceinline__ void run(f32x2 (&)[32], const f32x2 (&)[31], const LAS unsigned*, int) {} };

__device__ __forceinline__ void gemv_item(const float* cvec, const float* w_ada, float* MODP, LAS unsigned char* L, int nchunk, int ks, int tid, int lane, int wave) {
    const int k0 = ks * 256 + wave * 32, n0 = nchunk * 256 + lane * 4;
    float ca0 = 0.f, ca1 = 0.f;
    if (lane < 32) { const float c0 = cvec[k0 + lane], c1 = cvec[2048 + k0 + lane]; ca0 = c0 / (1.0f + expf(-c0)); ca1 = c1 / (1.0f + expf(-c1)); }
    f32x4 a0 = {0.f, 0.f, 0.f, 0.f}, a1 = a0;
#pragma unroll
    for (int r = 0; r < 32; ++r) { const f32x4 w = __builtin_nontemporal_load((const __attribute__((address_space(1))) f32x4*)(w_ada + (size_t)(k0 + r) * 6144 + n0));
        const float s0 = __shfl(ca0, r), s1 = __shfl(ca1, r); a0 += s0 * w; a1 += s1 * w; }
    LAS f32x4* red = (LAS f32x4*)L;
    red[(wave * 2 + 0) * 64 + lane] = a0; red[(wave * 2 + 1) * 64 + lane] = a1;
    __syncthreads();
    { const int b = tid >> 8, col = tid & 255; const LAS float* rf = (const LAS float*)L; float s = 0.f;
#pragma unroll
      for (int w = 0; w < 8; ++w) s += rf[(w * 2 + b) * 256 + col];
      MODP[(size_t)(ks * 2 + b) * 6144 + nchunk * 256 + col] = s; }
    __syncthreads();
}

struct Args { const void* in[20]; float* out; unsigned char* ws; int ph_lo, ph_hi; };

#define WSL(var) unsigned char* var = args.ws; asm volatile("" : "+s"(var))
#define SMALLP(wsl, off) ((const float*)((wsl) + WS_SMALL) + (off))

__global__ void __launch_bounds__(NWAVES * 64, 2) mk_fwd(Args args) {
    extern __shared__ __attribute__((aligned(16))) unsigned char lds[];
    const int tid = threadIdx.x, wave = __builtin_amdgcn_readfirstlane(tid >> 6);
    const int G = gridDim.x, bx = blockIdx.x;
#define PHASE_LANE int lane_ = tid & 63; asm volatile("" : "+v"(lane_)); const int lane = lane_
    LAS unsigned char* L = (LAS unsigned char*)lds;
    const int lo = args.ph_lo, hi = args.ph_hi;
#define IN(k) (lo <= (k) && (k) < hi)
#define SEAM(k) do { if (IN(k) && IN((k) + 1)) xcd_barrier(bar); } while (0)
    for (int u = tid; u < (LDS_BYTES - RING_BYTES) / 4; u += NWAVES * 64) ((LAS unsigned*)(L + RING_BYTES))[u] = 0u;
    __syncthreads();
    XcdBarrier bar; bar.bar = (unsigned*)(args.ws + WS_CTL); bar.x = 0; bar.st = nullptr;
    if (hi - lo > 1) bar = xcd_barrier_post((unsigned*)(args.ws + WS_CTL), (volatile LAS unsigned*)(L + MISC_OFF) + 8);

    if (IN(0)) for (int rep_ = 0; rep_ < REP[0]; ++rep_) {
        WSL(wsl);
        PHASE_LANE;
        const float* cvec = (const float*)args.in[1]; const int* pos = (const int*)args.in[2]; const float* w_ada = (const float*)args.in[4];
        const float* w_in = (const float*)args.in[6]; const float* w_pw = (const float*)args.in[16]; const float* w_out = (const float*)args.in[18];
        bf16* WIN_T = (bf16*)(wsl + WS_WIN); bf16* WOUT_T = (bf16*)(wsl + WS_WOUT); bf16* WPW_T = (bf16*)(wsl + WS_WPW);
        float* MODP = (float*)(wsl + WS_MODP); float* CS = (float*)(wsl + WS_CS); float* SM = (float*)(wsl + WS_SMALL);
        const int vcu = (G % 8 == 0) ? (bx % 8) * (G / 8) + bx / 8 : bx;
        { const int gt = bx * 512 + tid, GT = G * 512;
          { const int e = (G * 512 - 1) - gt;
            if (e < S_END) { const float* src; int o;
              if (e < S_SUBLN) { src = (const float*)args.in[7 + (e >> 6)]; o = e & 63; }
              else if (e < S_DWB) { src = (const float*)args.in[11]; o = e - S_SUBLN; }
              else if (e < S_LNG) { src = (const float*)args.in[13]; o = e - S_DWB; }
              else if (e < S_LNB) { src = (const float*)args.in[14]; o = e - S_LNG; }
              else if (e < S_BPW) { src = (const float*)args.in[15]; o = e - S_LNB; }
              else if (e < S_FG) { src = (const float*)args.in[17]; o = e - S_BPW; }
              else if (e < S_NG) { src = (const float*)args.in[19]; o = e - S_FG; }
              else if (e < S_BADA) { src = (const float*)args.in[3]; o = e - S_NG; }
              else if (e < S_DWW) { src = (const float*)args.in[5]; o = e - S_BADA; }
              else { src = (const float*)args.in[12]; o = e - S_DWW; }
              SM[e] = src[o]; } }
        }
        if (bx == 0 && tid == 0) { const void** pp = (const void**)(wsl + WS_PTRS); pp[0] = args.in[1]; pp[1] = args.in[4]; pp[2] = args.in[18]; }
        for (int item = bx; item < 128; item += G) gemv_item(cvec, w_ada, MODP, L, item % 16, item / 16, tid, lane, wave);
        { LAS float* scr = (LAS float*)(L + wave * 16384);
          const int gw = vcu * NWAVES + wave, NGW = G * NWAVES;
          constexpr int I_IN = 32 * 224, I_PW = 16 * 32;
          const int NPRE = (G == 256) ? 3072 : 0;
          for (int q = 0; q < 3 + (I_IN + I_PW - NPRE + NGW - 1) / NGW; ++q) {
              int it;
              if (q < 3) { if (NPRE == 0 || bx < 128) continue; it = ((bx - 128) * NWAVES + wave) + 1024 * q; }
              else { it = NPRE + gw + (q - 3) * NGW; if (it >= I_IN + I_PW) break; }
              int r = it;
              if (r < I_IN) { p0_transpose_item(w_in, 2048, DIN, WIN_T, true, scr, r, lane); continue; } r -= I_IN;
              p0_transpose_item(w_pw, 1024, 1024, WPW_T, false, scr, r, lane);
          } }
        for (int idx = bx * 512 + tid; idx < M * 8; idx += G * 512) { const int m = idx >> 3, i = idx & 7;
            const float ang = (float)pos[m] * rope_invf(i);
            const double a = (double)ang * 0.15915494309189535; const float f = (float)(a - rint(a));
            CS[(size_t)m * 16 + i] = __builtin_amdgcn_cosf(f); CS[(size_t)m * 16 + 8 + i] = __builtin_amdgcn_sinf(f); }
        __syncthreads();
    }
    SEAM(0);

    if (IN(1)) for (int rep_ = 0; rep_ < REP[1]; ++rep_) {
        WSL(wsl);
        PHASE_LANE;
        const float* x = (const float*)args.in[0]; const float* b_ada = SMALLP(wsl, S_BADA); const float* norm_g = SMALLP(wsl, S_NG);
        const float* MODP = (const float*)(wsl + WS_MODP); float* MODF = (float*)(wsl + WS_MODF); bf16* HN = (bf16*)(wsl + WS_HN);
        LAS float* tabA = (LAS float*)L; LAS float* tabB = tabA + 2048;
        for (int rb = bx; rb < M / 32; rb += G) {
            const int b = (rb * 32) / SEQ;
#pragma unroll
            for (int k = tid; k < 2048; k += 512) { float sh = b_ada[k], sc = b_ada[2048 + k];
#pragma unroll
                for (int ks = 0; ks < 8; ++ks) { sh += MODP[(size_t)(ks * 2 + b) * 6144 + k]; sc += MODP[(size_t)(ks * 2 + b) * 6144 + 2048 + k]; }
                tabA[k] = norm_g[k] * (1.0f + sc); tabB[k] = sh; }
            __syncthreads();
#pragma unroll 1
            for (int rr = 0; rr < 4; rr += 2) { const int m = rb * 32 + wave * 4 + rr;
                const f32x4* xr0 = (const f32x4*)(x + (size_t)m * DM) + lane; const f32x4* xr1 = xr0 + DM / 4; f32x4 v0[8], v1[8]; float s0 = 0.f, s1 = 0.f;
#pragma unroll
                for (int j = 0; j < 8; ++j) { v0[j] = __builtin_nontemporal_load((const __attribute__((address_space(1))) f32x4*)(xr0 + 64 * j)); v1[j] = __builtin_nontemporal_load((const __attribute__((address_space(1))) f32x4*)(xr1 + 64 * j)); }
#pragma unroll
                for (int j = 0; j < 8; ++j) { s0 += (v0[j].x * v0[j].x + v0[j].y * v0[j].y) + (v0[j].z * v0[j].z + v0[j].w * v0[j].w);
                                              s1 += (v1[j].x * v1[j].x + v1[j].y * v1[j].y) + (v1[j].z * v1[j].z + v1[j].w * v1[j].w); }
                const float rstd0 = 1.0f / sqrtf(wave_sum(s0) * (1.0f / DM) + EPS), rstd1 = 1.0f / sqrtf(wave_sum(s1) * (1.0f / DM) + EPS);
                v2u* o8 = (v2u*)(HN + (size_t)m * DM) + lane;
#pragma unroll
                for (int j = 0; j < 8; ++j) { const f32x4 A = *(const LAS f32x4*)(tabA + 4 * lane + 256 * j), B = *(const LAS f32x4*)(tabB + 4 * lane + 256 * j);
                    const f32x4 h0 = v0[j] * rstd0 * A + B, h1 = v1[j] * rstd1 * A + B; v2u w0, w1; w0.x = pk2(h0.x, h0.y); w0.y = pk2(h0.z, h0.w); w1.x = pk2(h1.x, h1.y); w1.y = pk2(h1.z, h1.w);
                    o8[64 * j] = w0; o8[DM / 4 + 64 * j] = w1; } }
            __syncthreads();
        }
    }
    SEAM(1);

    if (IN(2)) for (int rep_ = 0; rep_ < REP[2]; ++rep_) {
        WSL(wsl);
        bf16* HN = (bf16*)(wsl + WS_HN); bf16* WIN_T = (bf16*)(wsl + WS_WIN); bf16* QB = (bf16*)(wsl + WS_Q); bf16* KB = (bf16*)(wsl + WS_K); bf16* VB = (bf16*)(wsl + WS_V);
        bf16* SGA = (bf16*)(wsl + WS_SGA); bf16* YG = (bf16*)(wsl + WS_YG); bf16* SGC = (bf16*)(wsl + WS_SGC); const float* CS = (const float*)(wsl + WS_CS);
        pg8::Gemm g{HN, WIN_T, M, DIN, DM}; pg8::OrderSkipGA S; S.o.init(M, DIN - 1024, G, bx);
        pg8::EpiIn E{QB, KB, VB, SGA, YG, SGC, CS, attn_body::C2};
        pg8::gemm_phase<pg8::EpiIn, pg8::OrderSkipGA, PG8_ALIGN, PG8_SP2>(L, g, S, E);
    }
    SEAM(2);

    if (IN(3)) for (int rep_ = 0; rep_ < REP[3]; ++rep_) {
        WSL(wsl);
        PHASE_LANE;
        const bf16* YG = (const bf16*)(wsl + WS_YG); bf16* CL = (bf16*)(wsl + WS_CL);
        const float* dw_w = SMALLP(wsl, S_DWW); const float* dw_b = SMALLP(wsl, S_DWB); const float* ln_g = SMALLP(wsl, S_LNG); const float* ln_b = SMALLP(wsl, S_LNB);
        for (int tb = bx; tb < M / 32; tb += G) {
            const int m0 = tb * 32, t0 = m0 % SEQ;
            LAS v4u* ly = (LAS v4u*)L;
            { v4u sv[16];
#pragma unroll
              for (int i = 0; i < 16; ++i) { const int ch = tid + 512 * i, r = ch >> 7, cc = ch & 127; sv[i] = (v4u){0u, 0u, 0u, 0u};
                  if (ch < 62 * 128 && t0 - 30 + r >= 0) sv[i] = *(const v4u*)(YG + (size_t)(m0 - 30 + r) * 1024 + cc * 8); }
              f32x2 w[31];
#pragma unroll
              for (int j = 0; j < 31; ++j) w[j] = *(const f32x2*)(dw_w + j * 1024 + 2 * tid);
#pragma unroll
              for (int i = 0; i < 16; ++i) { const int ch = tid + 512 * i; if (ch < 62 * 128) ly[ch] = sv[i]; }
              __syncthreads();
              const f32x2 bias = *(const f32x2*)(dw_b + 2 * tid);
              const LAS unsigned* lyu = (const LAS unsigned*)L;
              f32x2 a[32];
#pragma unroll
              for (int t = 0; t < 32; ++t) a[t] = bias;
              ConvRow<0>::run(a, w, lyu, tid);
              float v[64];
#pragma unroll
              for (int t = 0; t < 32; ++t) { v[t] = a[t].x + a[t].y; v[32 + t] = a[t].x * a[t].x + a[t].y * a[t].y; }
#define BSTEP(h) { const bool up = (lane & (h)) != 0; _Pragma("unroll") for (int i = 0; i < (h); ++i) { const float snd = up ? v[i] : v[i + (h)], keep = up ? v[i + (h)] : v[i]; v[i] = keep + __shfl_xor(snd, (h)); } }
              BSTEP(32) BSTEP(16) BSTEP(8) BSTEP(4) BSTEP(2) BSTEP(1)
#undef BSTEP
              LAS float* red = (LAS float*)(L + 62 * 2048);
              red[wave * 64 + lane] = v[0];
              __syncthreads();
              if (tid < 32) { float sm = 0.f, q = 0.f;
#pragma unroll
                  for (int wv = 0; wv < 8; ++wv) { sm += red[wv * 64 + tid]; q += red[wv * 64 + 32 + tid]; }
                  const float mean = sm * (1.0f / 1024.0f), var = q * (1.0f / 1024.0f) - mean * mean;
                  *(LAS f32x2*)(L + 62 * 2048 + 2048 + 8 * tid) = (f32x2){mean, 1.0f / sqrtf(var + EPS)}; }
              __syncthreads();
              const f32x2 lg = *(const f32x2*)(ln_g + 2 * tid), lb = *(const f32x2*)(ln_b + 2 * tid);
#pragma unroll
              for (int t = 0; t < 32; ++t) { const f32x2 st = *(const LAS f32x2*)(L + 62 * 2048 + 2048 + 8 * t);
                  const f32x2 o = (a[t] - st.x) * st.y * lg + lb;
                  *(unsigned*)(CL + (size_t)(m0 + t) * 1024 + 2 * tid) = pk2(silu_f(o.x), silu_f(o.y)); }
            }
            __syncthreads();
        }
        asm volatile("s_waitcnt vmcnt(0)" ::: "memory"); __syncthreads();
        if (tid == 0) { __builtin_amdgcn_fence(__ATOMIC_RELEASE, "agent"); asm volatile("s_waitcnt vmcnt(0)" ::: "memory");
            __hip_atomic_fetch_add((unsigned*)(wsl + WS_CTL) + CW_CONV, 1u, __ATOMIC_RELAXED, __HIP_MEMORY_SCOPE_AGENT); }
        WSL(wsa);
        const attn_body::AttnTensors AT{(const attn_body::bf16*)(wsa + WS_Q), (const attn_body::bf16*)(wsa + WS_K), (const attn_body::bf16*)(wsa + WS_V), (attn_body::bf16*)(wsa + WS_O1), (attn_body::bf16*)(wsa + WS_O2)};
        const attn_body::StaticOrder S(G, bx);
        attn_body::attn_phase<attn_body::StaticOrder>((char*)lds, AT, S);
        { WSL(wsg);
          const int vcu = (bx % 8) * (G / 8) + bx / 8, idx = (vcu >> 3) * 4 + (vcu & 3);
          if (G == 256 && (vcu & 4) == 0) {
              unsigned* cw = (unsigned*)(wsg + WS_CTL) + CW_CONV;
              if (wave == 0) { unsigned sp = 0;
                  for (;;) { if ((unsigned)__builtin_amdgcn_readfirstlane(__hip_atomic_load(cw, __ATOMIC_RELAXED, __HIP_MEMORY_SCOPE_AGENT)) >= (unsigned)G) break;
                      if (++sp > (1u << 22)) break; __builtin_amdgcn_s_sleep(2); }
                  __builtin_amdgcn_fence(__ATOMIC_ACQUIRE, "agent"); }
              asm volatile("s_waitcnt vmcnt(0) lgkmcnt(0)" ::: "memory"); __syncthreads();
              pg8::Gemm g{(const bf16*)(wsg + WS_CL), (const bf16*)(wsg + WS_WPW), M, 1024, 1024}; pg8::OrderOne S1{idx >> 2, idx & 3};
              pg8::EpiPw E{SMALLP(wsg, S_BPW), (const bf16*)(wsg + WS_SGC), (bf16*)(wsg + WS_MIX)};
              pg8::gemm_phase<pg8::EpiPw, pg8::OrderOne, false, PG8_SP2>(L, g, S1, E);
          } else if (G == 256) {
              pg8::Gemm g{(const bf16*)(wsg + WS_HN), (const bf16*)(wsg + WS_WIN), M, DIN, DM}; pg8::OrderGA S1{idx};
              pg8::EpiIn E{(bf16*)(wsg + WS_Q), (bf16*)(wsg + WS_K), (bf16*)(wsg + WS_V), (bf16*)(wsg + WS_SGA), (bf16*)(wsg + WS_YG), (bf16*)(wsg + WS_SGC), (const float*)(wsg + WS_CS), attn_body::C2};
              pg8::gemm_phase<pg8::EpiIn, pg8::OrderGA, false, PG8_SP2>(L, g, S1, E);
              const int lane = tid & 63;
              const float* cvec = (const float*)((const void* const*)(wsg + WS_PTRS))[0]; const float* w_ada = (const float*)((const void* const*)(wsg + WS_PTRS))[1]; const float* w_out = (const float*)((const void* const*)(wsg + WS_PTRS))[2];
              { LAS float* scr = (LAS float*)(L + wave * 16384);
                p0_transpose_two(w_out, 2048, 2048, (bf16*)(wsg + WS_WOUT), scr, idx * NWAVES + wave, idx * NWAVES + wave + 128 * NWAVES, lane); }
              __syncthreads();
              if (idx < 64) gemv_item(cvec, w_ada, (float*)(wsg + WS_MODP), L, 16 + (idx & 7), idx >> 3, tid, lane, wave);
          } }
    }
    SEAM(3);

    if (IN(4)) for (int rep_ = 0; rep_ < REP[4]; ++rep_) {
        WSL(wsl);
        PHASE_LANE;
        bf16* MIX = (bf16*)(wsl + WS_MIX);
        const bf16* O1 = (const bf16*)(wsl + WS_O1); const bf16* O2 = (const bf16*)(wsl + WS_O2); const bf16* SGA = (const bf16*)(wsl + WS_SGA);
        const float* lamv = SMALLP(wsl, S_LAM); const float* subln_g = SMALLP(wsl, S_SUBLN);
        { const float* b_ada = SMALLP(wsl, S_BADA); const float* MODP = (const float*)(wsl + WS_MODP); float* MODF = (float*)(wsl + WS_MODF);
          for (int idx = bx * 512 + tid; idx < 2 * 2048; idx += G * 512) { const int b = idx >> 11, n = 4096 + (idx & 2047); float sgt = b_ada[n];
#pragma unroll
              for (int ks = 0; ks < 8; ++ks) sgt += MODP[(size_t)(ks * 2 + b) * 6144 + n];
              MODF[b * 6144 + n] = sgt; } }
        const float lam = expf(wave_sum(lamv[lane] * lamv[64 + lane])) - expf(wave_sum(lamv[128 + lane] * lamv[192 + lane])) + 0.2f;
        f32x4 sg[4];
#pragma unroll
        for (int i = 0; i < 4; ++i) sg[i] = *(const f32x4*)(subln_g + 16 * (lane & 7) + 4 * i) * 0.8f;
#pragma unroll 4
        for (int m = bx * NWAVES + wave; m < M; m += G * NWAVES) {
            const size_t off = (size_t)m * 1024 + 16 * lane;
#define NTL(p) __builtin_nontemporal_load((const __attribute__((address_space(1))) v4u*)(p))
            const v4u a0 = NTL(O1 + off), a1 = NTL(O1 + off + 8), b0 = NTL(O2 + off), b1 = NTL(O2 + off + 8);
            const v4u g0 = NTL(SGA + off), g1 = NTL(SGA + off + 8);
#undef NTL
            f32x4 o[4];
            o[0] = pg8::bf_lo4(a0.x, a0.y) - lam * pg8::bf_lo4(b0.x, b0.y); o[1] = pg8::bf_lo4(a0.z, a0.w) - lam * pg8::bf_lo4(b0.z, b0.w);
            o[2] = pg8::bf_lo4(a1.x, a1.y) - lam * pg8::bf_lo4(b1.x, b1.y); o[3] = pg8::bf_lo4(a1.z, a1.w) - lam * pg8::bf_lo4(b1.z, b1.w);
            float ss = 0.f;
#pragma unroll
            for (int i = 0; i < 4; ++i) ss += (o[i].x * o[i].x + o[i].y * o[i].y) + (o[i].z * o[i].z + o[i].w * o[i].w);
            ss += __shfl_xor(ss, 1); ss += __shfl_xor(ss, 2); ss += __shfl_xor(ss, 4);
            const float rs = 1.0f / sqrtf(ss * (1.0f / 128.0f) + EPS);
            const f32x4 y0 = o[0] * rs * sg[0] * pg8::bf_lo4(g0.x, g0.y), y1 = o[1] * rs * sg[1] * pg8::bf_lo4(g0.z, g0.w);
            const f32x4 y2 = o[2] * rs * sg[2] * pg8::bf_lo4(g1.x, g1.y), y3 = o[3] * rs * sg[3] * pg8::bf_lo4(g1.z, g1.w);
            bf16* dst = MIX + (size_t)m * 2048 + 16 * lane;
            pg8::store8(dst, y0, y1); pg8::store8(dst + 8, y2, y3);
        }
    }
    SEAM(4);

    if (IN(5)) for (int rep_ = 0; rep_ < REP[5]; ++rep_) {
        WSL(wsl);
        const float* x = (const float*)args.in[0]; float* out = args.out;
        bf16* MIX = (bf16*)(wsl + WS_MIX); bf16* WOUT_T = (bf16*)(wsl + WS_WOUT); const float* MODF = (const float*)(wsl + WS_MODF);
        pg8::Gemm g{MIX, WOUT_T, M, 2048, 2048}; pg8::StaticOrder S; S.init(M, 2048, G, bx); S.wgm = 4;
        pg8::EpiOutNorm E{x, MODF, SMALLP(wsl, S_FG), out, (unsigned*)(wsl + WS_PART), (unsigned*)(wsl + WS_CTL) + CW_PANEL, EPS};
        pg8::gemm_phase<pg8::EpiOutNorm, pg8::StaticOrder, false, PG8_SP2>(L, g, S, E);
    }
#undef IN
#undef SEAM
}

extern "C" void kernel_launch(void* const* d_in, const int* in_sizes, int n_in, void* d_out, int out_size, void* d_ws, size_t ws_size, hipStream_t stream) {
    static int grid = 0;
    if (grid == 0) {
        if (n_in != 20 || out_size != M * DM || ws_size < WS_END) { fprintf(stderr, "kernel_launch: unexpected shapes (n_in %d, out %d, ws %zu); nothing launched\n", n_in, out_size, ws_size); grid = -1; return; }
        int dev = 0, cus = 0, per_cu = 0;
        if (hipGetDevice(&dev) != hipSuccess || hipDeviceGetAttribute(&cus, hipDeviceAttributeMultiprocessorCount, dev) != hipSuccess) { grid = -1; return; }
        if (hipFuncSetAttribute((const void*)mk_fwd, hipFuncAttributeMaxDynamicSharedMemorySize, LDS_BYTES) != hipSuccess) { fprintf(stderr, "kernel_launch: hipFuncSetAttribute failed\n"); grid = -1; return; }
        if (hipOccupancyMaxActiveBlocksPerMultiprocessor(&per_cu, (const void*)mk_fwd, NWAVES * 64, LDS_BYTES) != hipSuccess || per_cu < 1) { fprintf(stderr, "kernel_launch: occupancy query says %d blocks per CU\n", per_cu); (void)hipGetLastError(); per_cu = 1; }
        grid = cus * 1;
        if (grid > 256) grid = 256;
    }
    if (grid < 0) return;
    if (hipMemsetAsync((char*)d_ws + WS_CTL, 0, CTL_ZERO_BYTES, stream) != hipSuccess) { fprintf(stderr, "kernel_launch: hipMemsetAsync failed\n"); return; }
    Args a{};
    for (int i = 0; i < 20; ++i) a.in[i] = d_in[i];
    a.out = (float*)d_out; a.ws = (unsigned char*)d_ws;
    if (N_LAUNCHES == 1) {
        a.ph_lo = 0; a.ph_hi = N_PHASES;
        void* kargs[] = {&a};
        hipError_t e = hipLaunchCooperativeKernel((const void*)mk_fwd, dim3(grid), dim3(NWAVES * 64), kargs, LDS_BYTES, stream);
        if (e != hipSuccess) fprintf(stderr, "kernel_launch: cooperative launch failed: %s (grid %d)\n", hipGetErrorString(e), grid);
    } else {
        for (int p = 0; p < N_PHASES; ++p) { a.ph_lo = p; a.ph_hi = p + 1;
            hipLaunchKernelGGL(mk_fwd, dim3(grid), dim3(NWAVES * 64), LDS_BYTES, stream, a); }
    }
}
```
